# Optimizing an MI355X kernel written in HIP

```python
import jax, jax.numpy as jnp
from jax import lax
import numpy as np

D_MODEL = 1024
BATCH = 8
SEQ = 4096
DEPTH = 2

N_MIXERS = 2
CONV_WIDTH = 3
ML_HEADS = 8
ML_QK_DIM = D_MODEL // (2 * ML_HEADS)
ML_V_DIM = D_MODEL // ML_HEADS
ML_QK_W = ML_HEADS * ML_QK_DIM
ML_V_W = ML_HEADS * ML_V_DIM
ML_PROJ_W = 2 * ML_QK_W + 2 * ML_V_W + 2 * ML_HEADS
ML_CHUNK = 64
N_EXPERTS = 16
N_GROUPS = 4
EXPERTS_PER_GROUP = N_EXPERTS // N_GROUPS
TOP_K = 2
D_EXPERT = 3 * D_MODEL // 2
DISPATCH_BLOCK = 256
ALPHA = (2 * DEPTH) ** 0.25
BETA = (8 * DEPTH) ** -0.25
LN_EPS = 1e-5
HEAD_NORM_EPS = 1e-6
N_CONV_LAYERS = (DEPTH + 1) // 2
N_MLSTM_LAYERS = DEPTH // 2

kernel_name = "hybrid_conv_mlstm_shared_router_moe_deepnorm"


def layer_norm(x, g, b):
    xf = x.astype(jnp.float32)
    mu = jnp.mean(xf, axis=-1, keepdims=True)
    xc = xf - mu
    var = jnp.mean(xc * xc, axis=-1, keepdims=True)
    return (xc * lax.rsqrt(var + LN_EPS) * g.astype(jnp.float32) + b.astype(jnp.float32)).astype(x.dtype)


def short_conv_mixer(x, w_in, w_conv, w_out):
    d = x.shape[-1]
    proj = x @ w_in
    gate_b, gate_c, h = jnp.split(proj, 3, axis=-1)
    u = gate_c * h
    conv = lax.conv_general_dilated(
        u, w_conv[:, None, :], window_strides=(1,), padding=[(CONV_WIDTH - 1, 0)],
        dimension_numbers=("NWC", "WIO", "NWC"), feature_group_count=d)
    return (gate_b * conv) @ w_out


def mlstm_chunkwise(q, k, v, log_i, log_f):
    bsz, nh, s, dk = q.shape
    dv = v.shape[-1]
    L = ML_CHUNK
    nc = s // L

    def to_chunks(a):
        a = a.reshape(a.shape[:2] + (nc, L) + a.shape[3:])
        return jnp.moveaxis(a, 2, 0)

    causal = jnp.tril(jnp.ones((L, L), dtype=bool))

    def step(carry, inp):
        c_state, n_state, m_state = carry
        qc, kc, vc, ic, fc = inp
        b = jnp.cumsum(fc, axis=-1)
        d_mat = b[..., :, None] - b[..., None, :] + ic[..., None, :]
        d_mat = jnp.where(causal, d_mat, -jnp.inf)
        m_inter = b + m_state[..., None]
        m_t = jnp.maximum(m_inter, jnp.max(d_mat, axis=-1))
        w_inter = jnp.exp(m_inter - m_t)
        p = jnp.exp(d_mat - m_t[..., None])
        a = p * jnp.einsum("bhld,bhrd->bhlr", qc, kc)
        num = jnp.einsum("bhlr,bhrv->bhlv", a, vc) + w_inter[..., None] * jnp.einsum("bhld,bhdv->bhlv", qc, c_state)
        den = jnp.sum(a, axis=-1) + w_inter * jnp.einsum("bhld,bhd->bhl", qc, n_state)
        h = num / jnp.maximum(jnp.abs(den), jnp.exp(-m_t))[..., None]
        m_new = m_t[..., -1]
        g_state = jnp.exp(b[..., -1] + m_state - m_new)
        g_r = jnp.exp(b[..., -1:] - b + ic - m_new[..., None])
        c_new = g_state[..., None, None] * c_state + jnp.einsum("bhr,bhrd,bhrv->bhdv", g_r, kc, vc)
        n_new = g_state[..., None] * n_state + jnp.einsum("bhr,bhrd->bhd", g_r, kc)
        return (c_new, n_new, m_new), h

    init = (jnp.zeros((bsz, nh, dk, dv), jnp.float32),
            jnp.zeros((bsz, nh, dk), jnp.float32),
            jnp.zeros((bsz, nh), jnp.float32))
    _, hs = lax.scan(step, init, tuple(to_chunks(a) for a in (q, k, v, log_i, log_f)))
    hs = jnp.moveaxis(hs, 0, 2)
    return hs.reshape(bsz, nh, s, dv)


def mlstm_mixer(x, w_in, b_gate, norm_g, w_out):
    bsz, s, d = x.shape
    proj = x @ w_in
    q, k, v, o_pre, gates = jnp.split(
        proj, [ML_QK_W, 2 * ML_QK_W, 2 * ML_QK_W + ML_V_W, 2 * ML_QK_W + 2 * ML_V_W], axis=-1)
    f32 = jnp.float32
    heads = lambda a, hd: a.reshape(bsz, s, ML_HEADS, hd).transpose(0, 2, 1, 3).astype(f32)
    q = heads(q, ML_QK_DIM) * (ML_QK_DIM ** -0.5)
    k = heads(k, ML_QK_DIM)
    v = heads(v, ML_V_DIM)
    gates = (gates.astype(f32) + b_gate.astype(f32)).transpose(0, 2, 1)
    log_i = gates[:, :ML_HEADS]
    log_f = jax.nn.log_sigmoid(gates[:, ML_HEADS:])
    h = mlstm_chunkwise(q, k, v, log_i, log_f).transpose(0, 2, 1, 3)
    h = h * lax.rsqrt(jnp.mean(h * h, axis=-1, keepdims=True) + HEAD_NORM_EPS)
    h = h * norm_g.astype(f32).reshape(ML_HEADS, ML_V_DIM)
    o = jax.nn.sigmoid(o_pre.astype(f32)).reshape(bsz, s, ML_HEADS, ML_V_DIM)
    return (o * h).reshape(bsz, s, d).astype(x.dtype) @ w_out


def grouped_moe(x, router_w, router_b, w_gate, w_up, w_down):
    bsz, s, d = x.shape
    t = bsz * s
    xt = x.reshape(t, d)
    probs = jax.nn.softmax((xt @ router_w).astype(jnp.float32), axis=-1)
    sel = (probs + router_b.astype(jnp.float32)).reshape(t, N_GROUPS, EXPERTS_PER_GROUP)
    group_score = jnp.sum(lax.top_k(sel, TOP_K)[0], axis=-1)
    g_best = jnp.argmax(group_score, axis=-1)
    within = jnp.take_along_axis(sel, g_best[:, None, None], axis=1)[:, 0]
    _, local_idx = lax.top_k(within, TOP_K)
    expert_idx = g_best[:, None] * EXPERTS_PER_GROUP + local_idx
    gate = jnp.take_along_axis(probs, expert_idx, axis=1)
    gate = gate / jnp.sum(gate, axis=-1, keepdims=True)

    n_assign = t * TOP_K
    e_flat = expert_idx.reshape(-1).astype(jnp.int32)
    tok_flat = jnp.repeat(jnp.arange(t, dtype=jnp.int32), TOP_K)
    g_flat = gate.reshape(-1)
    order = jnp.argsort(e_flat)
    e_s, tok_s, g_s = e_flat[order], tok_flat[order], g_flat[order]
    counts = jnp.bincount(e_flat, length=N_EXPERTS).astype(jnp.int32)
    starts = jnp.cumsum(counts) - counts
    padded = (counts + DISPATCH_BLOCK - 1) // DISPATCH_BLOCK * DISPATCH_BLOCK
    pends = jnp.cumsum(padded)
    pstarts = pends - padded
    dest = pstarts[e_s] + (jnp.arange(n_assign, dtype=jnp.int32) - starts[e_s])
    n_rows = -(-n_assign // DISPATCH_BLOCK) * DISPATCH_BLOCK + N_EXPERTS * DISPATCH_BLOCK
    n_blocks = n_rows // DISPATCH_BLOCK
    block_start = jnp.arange(n_blocks, dtype=jnp.int32) * DISPATCH_BLOCK
    block_e = jnp.minimum(jnp.searchsorted(pends, block_start, side="right"), N_EXPERTS - 1)
    x_buf = jnp.zeros((n_rows, d), x.dtype).at[dest].set(xt[tok_s])

    def expert_block(args):
        xb, e = args
        hb = jax.nn.silu(xb @ w_gate[e]) * (xb @ w_up[e])
        return hb @ w_down[e]

    y_buf = lax.map(expert_block, (x_buf.reshape(n_blocks, DISPATCH_BLOCK, d), block_e))
    y_buf = y_buf.reshape(n_rows, d)
    y = jnp.zeros((t, d), x.dtype).at[tok_s].add(y_buf[dest] * g_s[:, None].astype(x.dtype))
    return y.reshape(bsz, s, d)


def setup_inputs(seed: int = 0) -> dict:
    key = jax.random.key(seed)
    ks = jax.random.split(key, 20)
    nrm = lambda k, shape, scale: jax.random.normal(k, shape, jnp.float32) * scale
    d = D_MODEL
    f_bias = jnp.linspace(3.0, 6.0, ML_HEADS, dtype=jnp.float32)
    b_gate = jnp.concatenate([
        nrm(ks[5], (N_MLSTM_LAYERS, ML_HEADS), 0.1),
        f_bias[None, :] + nrm(ks[6], (N_MLSTM_LAYERS, ML_HEADS), 0.1)], axis=-1)
    return {
        "x": nrm(ks[0], (BATCH, SEQ, d), 1.0),
        "conv_w_in": nrm(ks[1], (N_CONV_LAYERS, d, 3 * d), d ** -0.5),
        "conv_w": nrm(ks[2], (N_CONV_LAYERS, CONV_WIDTH, d), CONV_WIDTH ** -0.5),
        "conv_w_out": nrm(ks[3], (N_CONV_LAYERS, d, d), BETA * d ** -0.5),
        "ml_w_in": jnp.concatenate([
            nrm(ks[4], (N_MLSTM_LAYERS, d, 2 * ML_QK_W), d ** -0.5),
            nrm(ks[7], (N_MLSTM_LAYERS, d, ML_V_W), BETA * d ** -0.5),
            nrm(ks[8], (N_MLSTM_LAYERS, d, ML_V_W + 2 * ML_HEADS), d ** -0.5)], axis=-1),
        "ml_b_gate": b_gate,
        "ml_norm_g": 1.0 + nrm(ks[9], (N_MLSTM_LAYERS, ML_V_W), 0.02),
        "ml_w_out": nrm(ks[10], (N_MLSTM_LAYERS, d, d), BETA * d ** -0.5),
        "ln_mix_g": 1.0 + nrm(ks[11], (DEPTH, d), 0.02),
        "ln_mix_b": nrm(ks[12], (DEPTH, d), 0.02),
        "ln_ffn_g": 1.0 + nrm(ks[13], (DEPTH, d), 0.02),
        "ln_ffn_b": nrm(ks[14], (DEPTH, d), 0.02),
        "router_w": nrm(ks[15], (d, N_EXPERTS), d ** -0.5),
        "router_b": nrm(ks[16], (N_EXPERTS,), 0.01),
        "exp_w_gate": nrm(ks[17], (DEPTH, N_EXPERTS, d, D_EXPERT), BETA * d ** -0.5),
        "exp_w_up": nrm(ks[18], (DEPTH, N_EXPERTS, d, D_EXPERT), BETA * d ** -0.5),
        "exp_w_down": nrm(ks[19], (DEPTH, N_EXPERTS, D_EXPERT, d), BETA * D_EXPERT ** -0.5),
    }


def reference(x, conv_w_in, conv_w, conv_w_out, ml_w_in, ml_b_gate, ml_norm_g, ml_w_out,
              ln_mix_g, ln_mix_b, ln_ffn_g, ln_ffn_b, router_w, router_b,
              exp_w_gate, exp_w_up, exp_w_down):
    for i in range(DEPTH):
        j = i // N_MIXERS
        if i % N_MIXERS == 0:
            mix = short_conv_mixer(x, conv_w_in[j], conv_w[j], conv_w_out[j])
        else:
            mix = mlstm_mixer(x, ml_w_in[j], ml_b_gate[j], ml_norm_g[j], ml_w_out[j])
        x = layer_norm(ALPHA * x + mix, ln_mix_g[i], ln_mix_b[i])
        ffn = grouped_moe(x, router_w, router_b, exp_w_gate[i], exp_w_up[i], exp_w_down[i])
        x = layer_norm(ALPHA * x + ffn, ln_ffn_g[i], ln_ffn_b[i])
    return x
```

```cpp
#include <hip/hip_runtime.h>
#include <cstdio>
#include <cstdint>

#ifndef REP_MASK
#define REP_MASK 0
#endif
#ifndef MK_PER_PHASE
#define MK_PER_PHASE 0
#endif

#define LAS __attribute__((address_space(3)))
#define GAS __attribute__((address_space(1)))
typedef unsigned short bf16_t;
typedef short bf16x8 __attribute__((ext_vector_type(8)));
typedef short s16x4 __attribute__((ext_vector_type(4)));
typedef float f32x4 __attribute__((ext_vector_type(4)));
typedef float f32x2 __attribute__((ext_vector_type(2)));
typedef unsigned u32x4 __attribute__((ext_vector_type(4)));
typedef unsigned u32x2 __attribute__((ext_vector_type(2)));
typedef int i32x4 __attribute__((ext_vector_type(4)));
typedef int i32x8 __attribute__((ext_vector_type(8)));

constexpr int T = 32768, D = 1024, SEQ = 4096;
constexpr int NE = 16, DE = 1536, NROWS = 69632;
constexpr int NH = 8, NCH = 64, NBH = 64;
constexpr float ALPHA = 1.41421356237f;
constexpr float LN_EPS = 1e-5f, HN_EPS = 1e-6f;
constexpr int NWAVES = 8, NTHREADS = 512;

constexpr size_t MiB = 1u << 20;
constexpr size_t WS_CTL = 0, CTL_ZERO_BYTES = 1 * MiB;
constexpr size_t WS_TOK_E = 1 * MiB;
constexpr size_t WS_TOK_SLOT = 1 * MiB + 256 * 1024;
constexpr size_t WS_TOK_GATE = 1 * MiB + 512 * 1024;
constexpr size_t WS_GB = 2 * MiB, WS_GIB = 3 * MiB, WS_GCM = 4 * MiB;
constexpr size_t WS_CHST = 5 * MiB;
constexpr size_t WS_DN = 5 * MiB + 512 * 1024;
constexpr size_t WS_NST = 6 * MiB + 512 * 1024;
constexpr size_t WS_WC1 = 8 * MiB, WS_WC2 = 14 * MiB, WS_WM1 = 16 * MiB, WS_WM2 = 22 * MiB;
constexpr size_t WS_W13 = 24 * MiB;
constexpr size_t WS_W2 = 216 * MiB;
constexpr size_t WS_CST = 120 * MiB;
constexpr size_t WS_X8 = 184 * MiB;
constexpr size_t WS_SLOT_TOK = 264 * MiB;
constexpr size_t WS_WM1F8 = 268 * MiB;
constexpr size_t WS_V8 = 440 * MiB;
constexpr size_t WS_O8 = 736 * MiB;
constexpr size_t WS_WM1I8 = 272 * MiB;
constexpr size_t WS_WM2F8 = 270 * MiB;
constexpr size_t WS_XB = 312 * MiB;
constexpr size_t WS_BUFB = 376 * MiB;
constexpr size_t WS_BUFC = 512 * MiB;
constexpr size_t WS_HMIX = 704 * MiB;
constexpr size_t WS_END = 768 * MiB;
constexpr int CW_BAR = 4096;
constexpr int CW_CNT = 8192;

constexpr int RING_BYTES = 131072;
constexpr int MISC_OFF = 155648;
constexpr int TILE_E_OFF = MISC_OFF + 64;
constexpr int TINFO_OFF = MISC_OFF + 384;
constexpr int GTAB_OFF = MISC_OFF + 1024;
constexpr int LDS_BYTES = 163840;

__device__ __forceinline__ unsigned cvt_pk_bf16(float lo, float hi) { unsigned r; asm volatile("v_cvt_pk_bf16_f32 %0, %1, %2" : "=v"(r) : "v"(lo), "v"(hi)); return r; }
typedef __bf16 bf16x2_t __attribute__((ext_vector_type(2)));
__device__ __forceinline__ unsigned cvt_pk_bf16_c(float lo, float hi) { const f32x2 v = {lo, hi}; return __builtin_bit_cast(unsigned, __builtin_convertvector(v, bf16x2_t)); }
__device__ __forceinline__ float bf_lo(unsigned w) { return __uint_as_float(w << 16); }
__device__ __forceinline__ float bf_hi(unsigned w) { return __uint_as_float(w & 0xffff0000u); }
__device__ __forceinline__ float wave_sum(float v) {
    int x = (int)__float_as_uint(v);
#define WS_STEP(ctrl, rmask) x = (int)__float_as_uint(__uint_as_float((unsigned)x) + __uint_as_float((unsigned)__builtin_amdgcn_update_dpp(0, x, ctrl, rmask, 0xf, false)))
    WS_STEP(0x111, 0xf); WS_STEP(0x112, 0xf); WS_STEP(0x114, 0xf); WS_STEP(0x118, 0xf); WS_STEP(0x142, 0xa); WS_STEP(0x143, 0xc);
#undef WS_STEP
    return __uint_as_float((unsigned)__builtin_amdgcn_readlane(x, 63));
}
constexpr float SC_X = 16.0f, SC_H = 16.0f, SC_W = 256.0f, SC_INV = 1.0f / 4096.0f, SC_Y = 256.0f;
__device__ __forceinline__ unsigned pk4_fp8(float a, float b, float c, float d) { int w = 0; w = __builtin_amdgcn_cvt_pk_fp8_f32(a, b, w, false); w = __builtin_amdgcn_cvt_pk_fp8_f32(c, d, w, true); return (unsigned)w; }
__device__ __forceinline__ unsigned pk4_fp8_sat(float a, float b, float c, float d) { return pk4_fp8(__builtin_amdgcn_fmed3f(a, -448.f, 448.f), __builtin_amdgcn_fmed3f(b, -448.f, 448.f), __builtin_amdgcn_fmed3f(c, -448.f, 448.f), __builtin_amdgcn_fmed3f(d, -448.f, 448.f)); }
constexpr float SI_X = 26.0f, SI_W = 900.0f, SI_WV = 1800.0f;
__device__ __forceinline__ unsigned pk4_i8(float a, float b, float c, float d, float s) {
    constexpr float M = 12582912.0f;
    const unsigned ua = __builtin_bit_cast(unsigned, __builtin_amdgcn_fmed3f(__builtin_fmaf(a, s, M), M - 127.0f, M + 127.0f)), ub = __builtin_bit_cast(unsigned, __builtin_amdgcn_fmed3f(__builtin_fmaf(b, s, M), M - 127.0f, M + 127.0f));
    const unsigned uc = __builtin_bit_cast(unsigned, __builtin_amdgcn_fmed3f(__builtin_fmaf(c, s, M), M - 127.0f, M + 127.0f)), ud = __builtin_bit_cast(unsigned, __builtin_amdgcn_fmed3f(__builtin_fmaf(d, s, M), M - 127.0f, M + 127.0f));
    return __builtin_amdgcn_perm(ub, ua, 0x0c0c0400u) | __builtin_amdgcn_perm(ud, uc, 0x04000c0cu);
}
constexpr float SV8 = 55.0f, SO8 = 26.0f;
__device__ __forceinline__ float ubf(unsigned w, int k) { return (float)((w >> (8 * k)) & 0xffu); }
__device__ __forceinline__ u32x4 u8x8_bf16(u32x2 b, float inv) { const float off = -128.0f * inv; u32x4 o;
    o.x = cvt_pk_bf16(__builtin_fmaf(ubf(b.x, 0), inv, off), __builtin_fmaf(ubf(b.x, 1), inv, off)); o.y = cvt_pk_bf16(__builtin_fmaf(ubf(b.x, 2), inv, off), __builtin_fmaf(ubf(b.x, 3), inv, off));
    o.z = cvt_pk_bf16(__builtin_fmaf(ubf(b.y, 0), inv, off), __builtin_fmaf(ubf(b.y, 1), inv, off)); o.w = cvt_pk_bf16(__builtin_fmaf(ubf(b.y, 2), inv, off), __builtin_fmaf(ubf(b.y, 3), inv, off)); return o; }
#define LDS_WAIT() asm volatile("s_waitcnt lgkmcnt(0)" ::: "memory")
#define VM_WAIT() asm volatile("s_waitcnt vmcnt(0)" ::: "memory")

#define XB_TMO      128
#define XB_XCNT(j)  (256  + 64 * (j))
#define XB_XSUB(j)  (1280 + 64 * (j))
#define XB_XGEN(j)  (2304 + 64 * (j))
#define XB_TOP      3328
#define XB_TOPGEN   3392
#define XCD_BAR_WORDS 3456
#define XB_SPIN_CAP (1u << 18)
__device__ __forceinline__ unsigned xb_ld(unsigned* p)              { return __hip_atomic_load(p, __ATOMIC_RELAXED, __HIP_MEMORY_SCOPE_AGENT); }
__device__ __forceinline__ unsigned xb_add(unsigned* p, unsigned v) { return __hip_atomic_fetch_add(p, v, __ATOMIC_RELAXED, __HIP_MEMORY_SCOPE_AGENT); }
__device__ __forceinline__ unsigned xb_xcc_id() { return (unsigned)__builtin_amdgcn_s_getreg((3 << 11) | 20) & 0xFu; }
#define XB_SPIN(cond, bar) do { unsigned _sp = 0; while (cond) { __builtin_amdgcn_s_sleep(1); \
    if ((++_sp & 255u) == 0u) { if (xb_ld(&(bar)[XB_TMO])) break; if (_sp > XB_SPIN_CAP) { atomicAdd(&(bar)[XB_TMO], 1u); break; } } } } while (0)
struct XcdBarrier { unsigned* bar; unsigned x; volatile LAS unsigned* st; };
__device__ __forceinline__ XcdBarrier xcd_barrier_post(unsigned* bar, volatile LAS unsigned* st) {
    XcdBarrier b; b.bar = bar; b.x = xb_xcc_id(); b.st = st;
    if (threadIdx.x == 0) (void)xb_add(&bar[XB_XCNT(b.x)], 1u);
    return b;
}
__device__ __forceinline__ void xcd_barrier_complete(unsigned* bar, unsigned x, unsigned& nloc, unsigned& nx) {
    const unsigned G = gridDim.x * gridDim.y * gridDim.z;
    unsigned sum, cnt, mine, sp = 0u;
    for (;;) {
        sum = 0u; cnt = 0u; mine = 0u;
#pragma unroll
        for (unsigned j = 0; j < 16; ++j) { const unsigned c = xb_ld(&bar[XB_XCNT(j)]); sum += c; cnt += (c > 0u) ? 1u : 0u; mine = (j == x) ? c : mine; }
        if (sum == G) break;
        __builtin_amdgcn_s_sleep(1);
        if ((++sp & 255u) == 0u) { if (xb_ld(&bar[XB_TMO])) break; if (sp > XB_SPIN_CAP) { atomicAdd(&bar[XB_TMO], 1u); break; } }
    }
    nloc = mine > 0u ? mine : 1u; nx = cnt > 0u ? cnt : 1u;
}
__device__ __forceinline__ void xcd_barrier(const XcdBarrier& b) {
    asm volatile("s_waitcnt vmcnt(0)" ::: "memory");
    __syncthreads();
    if (threadIdx.x == 0) {
        unsigned* bar = b.bar;
        __builtin_amdgcn_s_waitcnt(0);
        unsigned nloc = b.st[0], nx = b.st[1];
        if (nloc == 0u) { xcd_barrier_complete(bar, b.x, nloc, nx); b.st[0] = nloc; b.st[1] = nx; }
        const unsigned old = xb_add(&bar[XB_XSUB(b.x)], 1u);
        const unsigned gen = old / nloc;
        if (old + 1u == (gen + 1u) * nloc) {
            __builtin_amdgcn_fence(__ATOMIC_RELEASE, "agent");
            asm volatile("s_waitcnt vmcnt(0)" ::: "memory");
            const unsigned og = xb_add(&bar[XB_TOP], 1u);
            const unsigned tg = og / nx;
            if (og + 1u == (tg + 1u) * nx) xb_add(&bar[XB_TOPGEN], 1u);
            else XB_SPIN(xb_ld(&bar[XB_TOPGEN]) == tg, bar);
            __builtin_amdgcn_fence(__ATOMIC_ACQUIRE, "agent");
            xb_add(&bar[XB_XGEN(b.x)], 1u);
            asm volatile("s_waitcnt vmcnt(0)" ::: "memory");
        } else {
            XB_SPIN(xb_ld(&bar[XB_XGEN(b.x)]) == gen, bar);
            __builtin_amdgcn_fence(__ATOMIC_ACQUIRE, "agent");
            asm volatile("s_waitcnt vmcnt(0)" ::: "memory");
        }
    }
    __syncthreads();
}

namespace pg8 {
constexpr int BM = 256, BK = 64, HALF = 128, HTB = HALF * BK * 2, STAGE_BYTES = 8 * HTB, NXCD = 8, WGM = 8;
__host__ __device__ __forceinline__ int lds_byte(int r, int c) { const int st = (r >> 4) * 2 + (c >> 5), rr = r & 15, cc = c & 31, ob = rr * 64 + cc * 2; return st * 1024 + (ob ^ (((ob >> 9) & 1) << 5)); }
__host__ __device__ __forceinline__ void stage_rc(int b, int& R, int& C) { const int st = b / 1024, sb = b % 1024, swz = sb ^ (((sb >> 9) & 1) << 5); R = (st >> 1) * 16 + swz / 64; C = (st & 1) * 32 + (swz % 64) / 2; }
__host__ __device__ __forceinline__ int perm32(int rho) { const int n = rho >> 4, i = rho & 15; return 8 * (i >> 2) + 4 * n + (i & 3); }

struct Unit { int pm, pn; };
struct Gemm { const bf16_t* A; const bf16_t* Bt; int K; int grouped; const LAS unsigned char* tile_e; size_t estride;
              const int* slot_tok; const LAS int* tinfo; LAS int* gtab; };

struct StaticOrder {
    int nM, nN, nwg, G, c;
    __device__ void init(int nM_, int nN_, int G_, int c_) { nM = nM_; nN = nN_; nwg = nM * nN; G = G_; c = c_; }
    __device__ bool next(int i, Unit& u) const {
        const long L = (long)i * G + c; if (L >= nwg) return false;
        int wgid = (int)L; { const int q = nwg / NXCD, r = nwg % NXCD, xcd = wgid % NXCD, off = wgid / NXCD; wgid = (xcd < r ? xcd * (q + 1) : r * (q + 1) + (xcd - r) * q) + off; }
        const int nig = WGM * nN, gid = wgid / nig, fm = gid * WGM, gsz = (nM - fm) < WGM ? (nM - fm) : WGM;
        u.pm = fm + ((wgid % nig) % gsz); u.pn = (wgid % nig) / gsz; return true;
    }
};

struct EpiBf16S {
    static constexpr bool PERM = true;
    bf16_t* O; int ldc; int nscale; float scale;
    __device__ __forceinline__ void operator()(const f32x4 (&acc)[2][2][4][2], const Unit& u, int wr, int wc, int fr, int fq) const {
        const int row0 = u.pm * BM + wr * 64 + fr, col0 = u.pn * BM + wc * 32 + 8 * fq;
        const float sc = (u.pn < nscale) ? scale : 1.0f;
#pragma unroll
        for (int ai = 0; ai < 2; ++ai)
#pragma unroll
            for (int m = 0; m < 4; ++m) { bf16_t* rowp = O + (size_t)(row0 + ai * HALF + m * 16) * ldc + col0;
#pragma unroll
                for (int bj = 0; bj < 2; ++bj) { const f32x4 v0 = acc[ai][bj][m][0] * sc, v1 = acc[ai][bj][m][1] * sc;
                    u32x4 w; w.x = cvt_pk_bf16(v0[0], v0[1]); w.y = cvt_pk_bf16(v0[2], v0[3]); w.z = cvt_pk_bf16(v1[0], v1[1]); w.w = cvt_pk_bf16(v1[2], v1[3]);
                    *(u32x4*)(rowp + bj * HALF) = w; } }
    }
};
struct EpiBf16SI8 {
    static constexpr bool PERM = true;
    bf16_t* O; int ldc; unsigned char* V8; unsigned char* O8;
    static constexpr float S0 = 1.0f / (SI_X * SI_W), SV = 1.0f / (SI_X * SI_WV), SQ = 0.125f * S0;
    __device__ __forceinline__ void operator()(const f32x4 (&acc)[2][2][4][2], const Unit& u, int wr, int wc, int fr, int fq) const {
        const int row0 = u.pm * BM + wr * 64 + fr;
        if (u.pn < 4) {
            const int col0 = u.pn * BM + wc * 32 + 8 * fq; const float s_ = (u.pn < 2) ? SQ : S0;
#pragma unroll
            for (int ai = 0; ai < 2; ++ai)
#pragma unroll
                for (int m = 0; m < 4; ++m) { bf16_t* rowp = O + (size_t)(row0 + ai * HALF + m * 16) * ldc + col0;
#pragma unroll
                    for (int bj = 0; bj < 2; ++bj) { const f32x4 v0 = __builtin_convertvector(__builtin_bit_cast(i32x4, acc[ai][bj][m][0]), f32x4) * s_, v1 = __builtin_convertvector(__builtin_bit_cast(i32x4, acc[ai][bj][m][1]), f32x4) * s_;
                        u32x4 w; w.x = cvt_pk_bf16(v0[0], v0[1]); w.y = cvt_pk_bf16(v0[2], v0[3]); w.z = cvt_pk_bf16(v1[0], v1[1]); w.w = cvt_pk_bf16(v1[2], v1[3]);
                        *(u32x4*)(rowp + bj * HALF) = w; } }
        } else {
            unsigned char* base = (u.pn < 8) ? V8 : O8; const float s8 = (u.pn < 8) ? SV * SV8 : S0 * SO8; const int cl = (u.pn & 3) * BM + wc * 32 + 8 * fq;
#pragma unroll
            for (int ai = 0; ai < 2; ++ai)
#pragma unroll
                for (int m = 0; m < 4; ++m) { unsigned char* rowp = base + (size_t)(row0 + ai * HALF + m * 16) * D + cl;
#pragma unroll
                    for (int bj = 0; bj < 2; ++bj) { const f32x4 v0 = __builtin_convertvector(__builtin_bit_cast(i32x4, acc[ai][bj][m][0]), f32x4), v1 = __builtin_convertvector(__builtin_bit_cast(i32x4, acc[ai][bj][m][1]), f32x4);
                        u32x2 w; w.x = pk4_i8(v0[0], v0[1], v0[2], v0[3], s8) ^ 0x80808080u; w.y = pk4_i8(v1[0], v1[1], v1[2], v1[3], s8) ^ 0x80808080u;
                        *(u32x2*)(rowp + bj * HALF) = w; } }
        }
    }
};
struct EpiResBf16 {
    static constexpr bool PERM = true;
    bf16_t* X; float alpha; float sc = 1.0f;
    __device__ __forceinline__ void operator()(const f32x4 (&acc)[2][2][4][2], const Unit& u, int wr, int wc, int fr, int fq) const {
        const int row0 = u.pm * BM + wr * 64 + fr, col0 = u.pn * BM + wc * 32 + 8 * fq;
        u32x4 r[2][4][2];
#pragma unroll
        for (int ai = 0; ai < 2; ++ai)
#pragma unroll
            for (int m = 0; m < 4; ++m)
#pragma unroll
                for (int bj = 0; bj < 2; ++bj) r[ai][m][bj] = *(const u32x4*)(X + (size_t)(row0 + ai * HALF + m * 16) * D + col0 + bj * HALF);
        asm volatile("" ::: "memory");
#pragma unroll
        for (int ai = 0; ai < 2; ++ai)
#pragma unroll
            for (int m = 0; m < 4; ++m) { bf16_t* rowp = X + (size_t)(row0 + ai * HALF + m * 16) * D + col0;
#pragma unroll
                for (int bj = 0; bj < 2; ++bj) { const f32x4 a0 = acc[ai][bj][m][0] * sc, a1 = acc[ai][bj][m][1] * sc; const u32x4 q = r[ai][m][bj]; u32x4 w;
                    w.x = cvt_pk_bf16(bf_lo(q.x) * alpha + a0[0], bf_hi(q.x) * alpha + a0[1]); w.y = cvt_pk_bf16(bf_lo(q.y) * alpha + a0[2], bf_hi(q.y) * alpha + a0[3]);
                    w.z = cvt_pk_bf16(bf_lo(q.z) * alpha + a1[0], bf_hi(q.z) * alpha + a1[1]); w.w = cvt_pk_bf16(bf_lo(q.w) * alpha + a1[2], bf_hi(q.w) * alpha + a1[3]);
                    *(u32x4*)(rowp + bj * HALF) = w; } }
    }
};
struct EpiMul {
    static constexpr bool PERM = true;
    bf16_t* O;
    __device__ __forceinline__ void operator()(const f32x4 (&acc)[2][2][4][2], const Unit& u, int wr, int wc, int fr, int fq) const {
        const int row0 = u.pm * BM + wr * 64 + fr, col0 = u.pn * HALF + wc * 32 + 8 * fq;
#pragma unroll
        for (int ai = 0; ai < 2; ++ai)
#pragma unroll
            for (int m = 0; m < 4; ++m) { bf16_t* rowp = O + (size_t)(row0 + ai * HALF + m * 16) * D + col0;
                const f32x4 p0 = acc[ai][0][m][0] * acc[ai][1][m][0], p1 = acc[ai][0][m][1] * acc[ai][1][m][1];
                u32x4 w; w.x = cvt_pk_bf16(p0[0], p0[1]); w.y = cvt_pk_bf16(p0[2], p0[3]); w.z = cvt_pk_bf16(p1[0], p1[1]); w.w = cvt_pk_bf16(p1[2], p1[3]);
                *(u32x4*)rowp = w; }
    }
};
struct EpiConvGate {
    static constexpr bool PERM = true;
    const bf16_t* U; const float* cw; bf16_t* Z;
    __device__ __forceinline__ void operator()(const f32x4 (&acc)[2][2][4][2], const Unit& u, int wr, int wc, int fr, int fq) const {
        const int row0 = u.pm * BM + wr * 64 + fr, col0 = u.pn * BM + wc * 32 + 8 * fq;
#pragma unroll
        for (int bj = 0; bj < 2; ++bj) { const int c = col0 + bj * HALF;
            f32x4 w0[2], w1[2], w2[2];
#pragma unroll
            for (int n = 0; n < 2; ++n) { const float* p = cw + c + 4 * n; w0[n] = *(const f32x4*)p; w1[n] = *(const f32x4*)(p + D); w2[n] = *(const f32x4*)(p + 2 * D); }
#pragma unroll
            for (int ai = 0; ai < 2; ++ai)
#pragma unroll
                for (int m = 0; m < 4; ++m) { const int r = row0 + ai * HALF + m * 16, t = r & (SEQ - 1);
                    const float m1 = t >= 1 ? 1.f : 0.f, m2 = t >= 2 ? 1.f : 0.f; const int r1 = r >= 1 ? r - 1 : 0, r2 = r >= 2 ? r - 2 : 0;
                    const u32x4 x0 = *(const u32x4*)(U + (size_t)r * D + c), x1 = *(const u32x4*)(U + (size_t)r1 * D + c), x2 = *(const u32x4*)(U + (size_t)r2 * D + c);
                    f32x4 z0, z1;
#pragma unroll
                    for (int q = 0; q < 2; ++q) {
                        z0[2 * q]     = acc[ai][bj][m][0][2 * q]     * (w2[0][2 * q]     * bf_lo(x0[q]) + m1 * w1[0][2 * q]     * bf_lo(x1[q]) + m2 * w0[0][2 * q]     * bf_lo(x2[q]));
                        z0[2 * q + 1] = acc[ai][bj][m][0][2 * q + 1] * (w2[0][2 * q + 1] * bf_hi(x0[q]) + m1 * w1[0][2 * q + 1] * bf_hi(x1[q]) + m2 * w0[0][2 * q + 1] * bf_hi(x2[q]));
                        z1[2 * q]     = acc[ai][bj][m][1][2 * q]     * (w2[1][2 * q]     * bf_lo(x0[2 + q]) + m1 * w1[1][2 * q]     * bf_lo(x1[2 + q]) + m2 * w0[1][2 * q]     * bf_lo(x2[2 + q]));
                        z1[2 * q + 1] = acc[ai][bj][m][1][2 * q + 1] * (w2[1][2 * q + 1] * bf_hi(x0[2 + q]) + m1 * w1[1][2 * q + 1] * bf_hi(x1[2 + q]) + m2 * w0[1][2 * q + 1] * bf_hi(x2[2 + q])); }
                    u32x4 w; w.x = cvt_pk_bf16(z0[0], z0[1]); w.y = cvt_pk_bf16(z0[2], z0[3]); w.z = cvt_pk_bf16(z1[0], z1[1]); w.w = cvt_pk_bf16(z1[2], z1[3]);
                    *(u32x4*)(Z + (size_t)r * D + c) = w;
                    if (m & 1) asm volatile("" ::: "memory"); }
        }
    }
};
struct EpiFp8S {
    static constexpr bool PERM = true;
    unsigned char* O; float scale;
    __device__ __forceinline__ void operator()(const f32x4 (&acc)[2][2][4][2], const Unit& u, int wr, int wc, int fr, int fq) const {
        const int row0 = u.pm * BM + wr * 64 + fr, col0 = u.pn * BM + wc * 32 + 8 * fq;
#pragma unroll
        for (int ai = 0; ai < 2; ++ai)
#pragma unroll
            for (int m = 0; m < 4; ++m) { unsigned char* rowp = O + (size_t)(row0 + ai * HALF + m * 16) * D + col0;
#pragma unroll
                for (int bj = 0; bj < 2; ++bj) { const f32x4 v0 = acc[ai][bj][m][0] * scale, v1 = acc[ai][bj][m][1] * scale;
                    u32x2 w; w.x = pk4_fp8_sat(v0[0], v0[1], v0[2], v0[3]); w.y = pk4_fp8_sat(v1[0], v1[1], v1[2], v1[3]);
                    *(u32x2*)(rowp + bj * HALF) = w; } }
    }
};
struct EpiSwiGLU8 {
    static constexpr bool PERM = true;
    unsigned char* O;
    __device__ __forceinline__ void operator()(const f32x4 (&acc)[2][2][4][2], const Unit& u, int wr, int wc, int fr, int fq) const {
        const int row0 = u.pm * BM + wr * 64 + fr, col0 = u.pn * HALF + wc * 32 + 8 * fq;
#pragma unroll
        for (int ai = 0; ai < 2; ++ai)
#pragma unroll
            for (int m = 0; m < 4; ++m) { unsigned char* rowp = O + (size_t)(row0 + ai * HALF + m * 16) * DE + col0;
                float h[8];
#pragma unroll
                for (int n = 0; n < 2; ++n)
#pragma unroll
                    for (int jp = 0; jp < 2; ++jp) { const f32x2 a = {acc[ai][0][m][n][2 * jp], acc[ai][0][m][n][2 * jp + 1]}, b = {acc[ai][1][m][n][2 * jp], acc[ai][1][m][n][2 * jp + 1]};
                        constexpr float KD = 1.0f / (SC_INV * SC_INV * SC_H); const f32x2 kd = {KD, KD};
                        const f32x2 e = a * (-1.44269504089f * SC_INV); const f32x2 t = {__builtin_amdgcn_exp2f(e[0]), __builtin_amdgcn_exp2f(e[1])};
                        const f32x2 d = __builtin_elementwise_fma(t, kd, kd); const f32x2 r = {__builtin_amdgcn_rcpf(d[0]), __builtin_amdgcn_rcpf(d[1])};
                        const f32x2 hh = (a * b) * r; h[n * 4 + 2 * jp] = hh[0]; h[n * 4 + 2 * jp + 1] = hh[1]; }
                u32x2 w; w.x = pk4_fp8_sat(h[0], h[1], h[2], h[3]); w.y = pk4_fp8_sat(h[4], h[5], h[6], h[7]);
                *(u32x2*)rowp = w; }
    }
};

template <class Epi, bool FP8 = false, bool ALIGN_EPI = true, bool GATHER = false, bool I8 = false>
__device__ __forceinline__ void gemm_phase(LAS unsigned char* lds, const Gemm g, const StaticOrder& S, const Epi& E, const int wave) {
    int lane_; asm volatile("v_mbcnt_lo_u32_b32 %0, -1, 0\n\tv_mbcnt_hi_u32_b32 %0, -1, %0" : "=v"(lane_));
    const int wid = wave, lane = lane_, tid = wid * 64 + lane, wr = wid >> 2, wc = wid & 3, fr = lane & 15, fq = lane >> 4;
    const int K = g.K, nt = K / BK;
    unsigned voffA[2], voffB[2]; int rowA[2];
#pragma unroll
    for (int i = 0; i < 2; ++i) { int R, C; stage_rc(tid * 16 + i * 8192, R, C); const int Rb = Epi::PERM ? ((R & ~31) + perm32(R & 31)) : R;
        voffA[i] = GATHER ? (unsigned)C * 2u : (unsigned)(R * K + C) * 2u; voffB[i] = (unsigned)(Rb * K + C) * 2u; rowA[i] = R; }
    const size_t kstep = (size_t)(BK * 2);
    const size_t hstep = (size_t)HALF * K * 2;
    const size_t tstep = 2 * hstep;
    const unsigned ldsw = (unsigned)wid * 1024u;
    const int aoff = lds_byte(wr * 64 + fr, fq * 8), boff = lds_byte(wc * 32 + fr, fq * 8);
#define PG8_SA(b, h) (((b) * 2 + (h)) * HTB)
#define PG8_SB(b, h) ((4 + (b) * 2 + (h)) * HTB)
#define PG8_STAGE(bufoff, gbase, voff) do { _Pragma("unroll") for (int _i = 0; _i < 2; ++_i) \
        __builtin_amdgcn_global_load_lds((const unsigned*)((const char*)(gbase) + (voff)[_i]), (LAS unsigned*)(lds + (bufoff) + ldsw + _i * 8192), 16, 0, 0); } while (0)
#define PG8_LD8(base) __builtin_shufflevector(*(const LAS i32x4*)(lds + (base)), *(const LAS i32x4*)(lds + (base) + 1024), 0, 1, 2, 3, 4, 5, 6, 7)
#define PG8_LDA(dst, b, h) do { _Pragma("unroll") for (int m = 0; m < 4; ++m) dst[m] = PG8_LD8(PG8_SA(b, h) + aoff + m * 2048); } while (0)
#define PG8_LDB(dst, b, h) do { _Pragma("unroll") for (int n = 0; n < 2; ++n) dst[n] = PG8_LD8(PG8_SB(b, h) + boff + n * 2048); } while (0)
#define PG8_LO4(x) __builtin_bit_cast(bf16x8, __builtin_shufflevector((x), (x), 0, 1, 2, 3))
#define PG8_HI4(x) __builtin_bit_cast(bf16x8, __builtin_shufflevector((x), (x), 4, 5, 6, 7))
#define PG8_MMA(ai, bj, At, Bt) do { __builtin_amdgcn_s_setprio(1); \
        if constexpr (FP8) { _Pragma("unroll") for (int m = 0; m < 4; ++m) _Pragma("unroll") for (int n = 0; n < 2; ++n) \
            asm volatile("v_mfma_f32_16x16x128_f8f6f4 %0, %1, %2, %0" : "+v"(acc[ai][bj][m][n]) : "v"(Bt[n]), "v"(At[m])); } \
        else if constexpr (I8) {   \
            _Pragma("unroll") for (int m = 0; m < 4; ++m) _Pragma("unroll") for (int n = 0; n < 2; ++n) \
                asm volatile("v_mfma_i32_16x16x64_i8 %0, %1, %2, %0" : "+v"(acc[ai][bj][m][n]) : "v"(__builtin_shufflevector(Bt[n], Bt[n], 0, 1, 2, 3)), "v"(__builtin_shufflevector(At[m], At[m], 0, 1, 2, 3))); \
            _Pragma("unroll") for (int m = 0; m < 4; ++m) _Pragma("unroll") for (int n = 0; n < 2; ++n) \
                asm volatile("v_mfma_i32_16x16x64_i8 %0, %1, %2, %0" : "+v"(acc[ai][bj][m][n]) : "v"(__builtin_shufflevector(Bt[n], Bt[n], 4, 5, 6, 7)), "v"(__builtin_shufflevector(At[m], At[m], 4, 5, 6, 7))); } \
        else { _Pragma("unroll") for (int m = 0; m < 4; ++m) _Pragma("unroll") for (int n = 0; n < 2; ++n) { \
            acc[ai][bj][m][n] = __builtin_amdgcn_mfma_f32_16x16x32_bf16(PG8_LO4(Bt[n]), PG8_LO4(At[m]), acc[ai][bj][m][n], 0, 0, 0); \
            acc[ai][bj][m][n] = __builtin_amdgcn_mfma_f32_16x16x32_bf16(PG8_HI4(Bt[n]), PG8_HI4(At[m]), acc[ai][bj][m][n], 0, 0, 0); } } \
        __builtin_amdgcn_s_setprio(0); } while (0)
#define PG8_WAIT_V(n) asm volatile("s_waitcnt vmcnt(" #n ")" ::: "memory")
#define PG8_WAIT_L(n) asm volatile("s_waitcnt lgkmcnt(" #n ")" ::: "memory")
#define PG8_BAR __builtin_amdgcn_s_barrier()
#define PG8_SCHED __builtin_amdgcn_sched_barrier(0)
#define PG8_BPTR(u) ((const char*)g.Bt + ((g.grouped ? (size_t)g.tile_e[(u).pm] * g.estride * 2 : (size_t)0) + (size_t)(u).pn * tstep))
#define PG8_GT_ISSUE(u, buf) do { if (wid < 4) { const int e_ = g.tile_e[(u).pm]; const int lrb_ = ((u).pm - g.tinfo[e_]) * 256; \
        __builtin_amdgcn_global_load_lds((const unsigned*)(g.slot_tok + (size_t)e_ * 32768 + lrb_ + wid * 64 + lane), (LAS unsigned*)(g.gtab + (buf) * 256 + wid * 64), 4, 0, 0); } } while (0)
#define PG8_GT_READ(u, buf, off) do { const int e_ = g.tile_e[(u).pm]; const int lrb_ = ((u).pm - g.tinfo[e_]) * 256, cnt_ = g.tinfo[16 + e_]; \
        _Pragma("unroll") for (int h_ = 0; h_ < 2; ++h_) _Pragma("unroll") for (int i_ = 0; i_ < 2; ++i_) { const int lr_ = h_ * HALF + rowA[i_]; const int v_ = g.gtab[(buf) * 256 + lr_]; \
            off[h_][i_] = (unsigned)((lrb_ + lr_ < cnt_) ? v_ : 0) * (unsigned)(2 * K) + voffA[i_]; } } while (0)
    Unit cur, nxt; int ui = 0;
    if (!S.next(0, cur)) return;
    unsigned goff[2][2], noff[2][2];
    if constexpr (GATHER) { PG8_GT_ISSUE(cur, 0); PG8_WAIT_V(0); PG8_BAR; PG8_GT_READ(cur, 0, goff);
#pragma unroll
        for (int h_ = 0; h_ < 2; ++h_)
#pragma unroll
            for (int i_ = 0; i_ < 2; ++i_) noff[h_][i_] = goff[h_][i_]; }
    f32x4 acc[2][2][4][2];
#pragma unroll
    for (int a = 0; a < 2; ++a)
#pragma unroll
        for (int b = 0; b < 2; ++b)
#pragma unroll
            for (int m = 0; m < 4; ++m)
#pragma unroll
                for (int n = 0; n < 2; ++n) acc[a][b][m][n] = (f32x4){0.f, 0.f, 0.f, 0.f};
    i32x8 At[4], B0[2], B1[2];
    const char* cA = GATHER ? (const char*)g.A : (const char*)g.A + (size_t)cur.pm * tstep; const char* cB = PG8_BPTR(cur);
#define PG8_STAGE_A(bufoff, gbase, h, offs) do { if constexpr (GATHER) PG8_STAGE(bufoff, gbase, (offs)[h]); else PG8_STAGE(bufoff, (gbase) + (h) * hstep, voffA); } while (0)
    PG8_STAGE(PG8_SB(0, 0), cB, voffB); PG8_STAGE(PG8_SB(0, 1), cB + hstep, voffB); PG8_STAGE_A(PG8_SA(0, 0), cA, 0, goff); PG8_STAGE_A(PG8_SA(0, 1), cA, 1, goff);
    if (wr == 1) PG8_BAR;
    PG8_WAIT_V(2); PG8_BAR;
    PG8_STAGE(PG8_SB(1, 0), cB + kstep, voffB); PG8_STAGE_A(PG8_SA(1, 0), cA + kstep, 0, goff); PG8_STAGE(PG8_SB(1, 1), cB + hstep + kstep, voffB);
    PG8_WAIT_V(6); PG8_BAR;
    for (;;) {
        const bool has_next = S.next(ui + 1, nxt);
        const char* nA = GATHER ? cA : (has_next ? (const char*)g.A + (size_t)nxt.pm * tstep : cA); const char* nB = has_next ? PG8_BPTR(nxt) : cB;
        if constexpr (GATHER) { if (has_next) PG8_GT_ISSUE(nxt, (ui + 1) & 1); }
        for (int t = 0; t < nt; t += 2) {
            const bool last = (t == nt - 2);
            unsigned o2[2][2];
            if constexpr (GATHER) {
                if (last && has_next) PG8_GT_READ(nxt, (ui + 1) & 1, noff);
#pragma unroll
                for (int h_ = 0; h_ < 2; ++h_)
#pragma unroll
                    for (int i_ = 0; i_ < 2; ++i_) o2[h_][i_] = last ? noff[h_][i_] : goff[h_][i_]; }
            const char* a1 = cA + (size_t)(t + 1) * kstep;
            const char* a2 = last ? nA : cA + (size_t)(t + 2) * kstep; const char* b2 = last ? nB : cB + (size_t)(t + 2) * kstep;
            const char* a3 = a2 + kstep; const char* b3 = b2 + kstep;
            PG8_LDB(B0, 0, 0); PG8_LDB(B1, 0, 1); PG8_SCHED; PG8_LDA(At, 0, 0); PG8_STAGE_A(PG8_SA(1, 1), a1, 1, goff);
            PG8_WAIT_V(8); PG8_WAIT_L(0); PG8_BAR; PG8_MMA(0, 0, At, B0); PG8_MMA(0, 1, At, B1); PG8_BAR; PG8_SCHED;
            PG8_LDA(At, 0, 1); PG8_STAGE(PG8_SB(0, 0), b2, voffB); PG8_STAGE(PG8_SB(0, 1), b2 + hstep, voffB); PG8_STAGE_A(PG8_SA(0, 0), a2, 0, o2);
            PG8_WAIT_V(8); PG8_WAIT_L(0); PG8_BAR; PG8_MMA(1, 0, At, B0); PG8_MMA(1, 1, At, B1); PG8_BAR; PG8_SCHED;
            PG8_LDB(B0, 1, 0); PG8_LDB(B1, 1, 1); PG8_SCHED; PG8_LDA(At, 1, 0); PG8_STAGE_A(PG8_SA(0, 1), a2, 1, o2);
            PG8_WAIT_V(8); PG8_WAIT_L(0); PG8_BAR; PG8_MMA(0, 0, At, B0); PG8_MMA(0, 1, At, B1); PG8_BAR; PG8_SCHED;
            PG8_LDA(At, 1, 1); PG8_STAGE(PG8_SB(1, 0), b3, voffB); PG8_STAGE(PG8_SB(1, 1), b3 + hstep, voffB); PG8_STAGE_A(PG8_SA(1, 0), a3, 0, o2);
            PG8_WAIT_V(8); PG8_WAIT_L(0); PG8_BAR; PG8_MMA(1, 0, At, B0); PG8_MMA(1, 1, At, B1); PG8_BAR; PG8_SCHED;
        }
        if constexpr (FP8 || I8) asm volatile("s_nop 15\n\ts_nop 15" ::: "memory");
        if constexpr (FP8) { if (has_next) {
            int l_; asm volatile("v_mbcnt_lo_u32_b32 %0, -1, 0\n\tv_mbcnt_hi_u32_b32 %0, -1, %0" : "=v"(l_)); const int kt_ = 2 * (nxt.pm & 7) + (wid >> 2), r_ = (wid & 3) * 64 + l_;
            if (kt_ < nt) __builtin_amdgcn_global_load_lds((const unsigned*)(nB + (size_t)r_ * (size_t)(K * 2) + (size_t)kt_ * kstep), (LAS unsigned*)(lds + 131072 + wid * 256), 4, 0, 0); } }
        if constexpr (ALIGN_EPI) { if (wr == 0) PG8_BAR; }
        E(acc, cur, wr, wc, fr, fq);
        if (!has_next) break;
#pragma unroll
        for (int a = 0; a < 2; ++a)
#pragma unroll
            for (int b = 0; b < 2; ++b)
#pragma unroll
                for (int m = 0; m < 4; ++m)
#pragma unroll
                    for (int n = 0; n < 2; ++n) acc[a][b][m][n] = (f32x4){0.f, 0.f, 0.f, 0.f};
        cur = nxt; cA = nA; cB = nB; ++ui;
        if constexpr (GATHER) {
#pragma unroll
            for (int h_ = 0; h_ < 2; ++h_)
#pragma unroll
                for (int i_ = 0; i_ < 2; ++i_) goff[h_][i_] = noff[h_][i_]; }
        if constexpr (ALIGN_EPI) { if (wr == 1) PG8_BAR; }
    }
    PG8_WAIT_V(0);
    if constexpr (!ALIGN_EPI) { if (wr == 0) PG8_BAR; }
    PG8_BAR;
#undef PG8_SA
#undef PG8_SB
#undef PG8_STAGE
#undef PG8_LDA
#undef PG8_LDB
#undef PG8_MMA
#undef PG8_LO4
#undef PG8_HI4
#undef PG8_LD8
#undef PG8_WAIT_V
#undef PG8_WAIT_L
#undef PG8_BAR
#undef PG8_SCHED
#undef PG8_BPTR
#undef PG8_STAGE_A
#undef PG8_GT_ISSUE
#undef PG8_GT_READ
}
}

struct Args { const float* in[17]; float* out; unsigned char* ws; int ph_lo, ph_hi; };

struct Ctx {
    LAS unsigned char* lds;
    unsigned char* ws; unsigned* ctl;
    int tid, lane, wave, G, bid;
};

__device__ __forceinline__ void transpose_item(const float* W, int ldn, int K, bf16_t* WT, int k0, int n0, int drow0, LAS float* scr, int lane) {
#pragma unroll 8
    for (int i = 0; i < 32; ++i) { const int kk = 2 * i + (lane >> 5); scr[kk * 33 + (lane & 31)] = W[(size_t)(k0 + kk) * ldn + n0 + (lane & 31)]; }
    LDS_WAIT(); asm volatile("" ::: "memory");
    const int c = lane & 7;
#pragma unroll
    for (int j = 0; j < 4; ++j) { const int n = (lane >> 3) + 8 * j; const LAS float* s = scr + (8 * c) * 33 + n;
        u32x4 o; o.x = cvt_pk_bf16(s[0 * 33], s[1 * 33]); o.y = cvt_pk_bf16(s[2 * 33], s[3 * 33]); o.z = cvt_pk_bf16(s[4 * 33], s[5 * 33]); o.w = cvt_pk_bf16(s[6 * 33], s[7 * 33]);
        *(u32x4*)(WT + (size_t)(drow0 + n) * K + k0 + 8 * c) = o; }
    LDS_WAIT(); asm volatile("" ::: "memory");
}
struct XItem { const float* src; unsigned char* dst; int ldn, K; };
__device__ __forceinline__ XItem expert_item(const Ctx& F, const Args& a, int r, int lane) {
    const int le = r / 576, rr = r - le * 576, kind = rr / 192, q = rr - kind * 192;
    const int nq = lane & 15, kr = lane >> 4; XItem x;
    if (kind < 2) { const int kb = q / 24, nb = q - kb * 24, n0 = 64 * nb, k0 = 128 * kb; x.ldn = 1536; x.K = 1024;
        x.src = (kind == 0 ? a.in[14] : a.in[15]) + (size_t)le * 1024 * 1536 + (size_t)(k0 + 32 * kr) * 1536 + n0 + 4 * nq;
        x.dst = (unsigned char*)(F.ws + WS_W13) + (size_t)le * 3072 * 1024 + (size_t)(256 * (n0 >> 7) + (n0 & 127) + 128 * kind + 4 * nq) * 1024 + k0 + 32 * kr; }
    else { const int kb = q / 16, nb = q - kb * 16, n0 = 64 * nb, k0 = 128 * kb; x.ldn = 1024; x.K = 1536;
        x.src = a.in[16] + (size_t)le * 1536 * 1024 + (size_t)(k0 + 32 * kr) * 1024 + n0 + 4 * nq;
        x.dst = (unsigned char*)(F.ws + WS_W2) + (size_t)le * 1024 * 1536 + (size_t)(n0 + 4 * nq) * 1536 + k0 + 32 * kr; }
    return x;
}
__device__ __forceinline__ void xitem_run(const XItem& x) {
    f32x4 v[32];
#pragma unroll
    for (int i = 0; i < 32; ++i) v[i] = *(const f32x4*)(x.src + (size_t)i * x.ldn);
#pragma unroll
    for (int j = 0; j < 4; ++j)
#pragma unroll
        for (int hh = 0; hh < 2; ++hh) { u32x4 o;
#pragma unroll
            for (int q = 0; q < 4; ++q) o[q] = pk4_fp8(v[16 * hh + 4 * q][j] * SC_W, v[16 * hh + 4 * q + 1][j] * SC_W, v[16 * hh + 4 * q + 2][j] * SC_W, v[16 * hh + 4 * q + 3][j] * SC_W);
            *(u32x4*)(x.dst + (size_t)j * x.K + 16 * hh) = o; }
}
__device__ __forceinline__ void xitem_run_i8(const XItem& x, float sc) {
    f32x4 v[32];
#pragma unroll
    for (int i = 0; i < 32; ++i) v[i] = *(const f32x4*)(x.src + (size_t)i * x.ldn);
#pragma unroll
    for (int j = 0; j < 4; ++j)
#pragma unroll
        for (int hh = 0; hh < 2; ++hh) { u32x4 o;
#pragma unroll
            for (int q = 0; q < 4; ++q) o[q] = pk4_i8(v[16 * hh + 4 * q][j], v[16 * hh + 4 * q + 1][j], v[16 * hh + 4 * q + 2][j], v[16 * hh + 4 * q + 3][j], sc);
            *(u32x4*)(x.dst + (size_t)j * x.K + 16 * hh) = o; }
}
__device__ __forceinline__ void p0_prologue(const Ctx& F, const Args& a) {
    LAS float* scr = (LAS float*)(F.lds + F.wave * 16384);
    const int gw = F.bid * NWAVES + F.wave, NGW = F.G * NWAVES;
    constexpr int I_A = 16 * 96, I_B = 16 * 32;
    constexpr int I_DENSE = I_A + 2 * I_B;
    for (int it = gw; it < I_DENSE; it += NGW) {
        int r = it;
        if (r < I_A) { const int n0 = 32 * (r % 96), ch = n0 & 1023;
            transpose_item(a.in[1], 3072, 1024, (bf16_t*)(F.ws + WS_WC1), 64 * (r / 96), n0, n0 < 1024 ? 2048 + n0 : 256 * (ch >> 7) + (ch & 127) + (n0 >= 2048 ? 128 : 0), scr, F.lane); continue; } r -= I_A;
        if (r < I_B) { transpose_item(a.in[3], 1024, 1024, (bf16_t*)(F.ws + WS_WC2), 64 * (r / 32), 32 * (r % 32), 32 * (r % 32), scr, F.lane); continue; } r -= I_B;
        transpose_item(a.in[7], 1024, 1024, (bf16_t*)(F.ws + WS_WM2), 64 * (r / 32), 32 * (r % 32), 32 * (r % 32), scr, F.lane);
    }
    const float* x = a.in[0]; bf16_t* xb = (bf16_t*)(F.ws + WS_XB);
    for (int m = gw; m < T; m += NGW) {
        const f32x4* xr = (const f32x4*)(x + (size_t)m * D) + F.lane; u32x2* o = (u32x2*)(xb + (size_t)m * D) + F.lane;
#pragma unroll
        for (int j = 0; j < 4; ++j) { const f32x4 v = xr[64 * j]; u32x2 w; w.x = cvt_pk_bf16(v[0], v[1]); w.y = cvt_pk_bf16(v[2], v[3]); o[64 * j] = w; }
    }
    constexpr int NX = 32 * 576;
    for (int it = gw; it < NX; it += NGW) { const XItem xi = expert_item(F, a, it, F.lane); xitem_run(xi); }
    for (int it = gw; it < 128; it += NGW) { const int kb = it >> 4, nb = it & 15, nq = F.lane & 15, kr = F.lane >> 4; XItem xi; xi.ldn = 1024; xi.K = 1024;
        xi.src = a.in[7] + (size_t)(128 * kb + 32 * kr) * 1024 + 64 * nb + 4 * nq; xi.dst = (unsigned char*)(F.ws + WS_WM2F8) + (size_t)(64 * nb + 4 * nq) * 1024 + 128 * kb + 32 * kr; xitem_run(xi); }
    for (int it = gw; it < 384; it += NGW) { const int kb = it / 48, nb = it - kb * 48, nq = F.lane & 15, kr = F.lane >> 4; XItem xi; xi.ldn = 3088; xi.K = 1024;
        xi.src = a.in[4] + (size_t)(128 * kb + 32 * kr) * 3088 + 64 * nb + 4 * nq; xi.dst = (unsigned char*)(F.ws + WS_WM1I8) + (size_t)(64 * nb + 4 * nq) * 1024 + 128 * kb + 32 * kr;
        xitem_run_i8(xi, (nb >= 16 && nb < 32) ? SI_WV : SI_W); }
}

__device__ __forceinline__ float reduce16(const float (&a)[16], int lane) {
    const bool h5 = (lane & 32) != 0, h4 = (lane & 16) != 0, h3 = (lane & 8) != 0, h2 = (lane & 4) != 0;
    float b[8], c[4], d[2];
#pragma unroll
    for (int i = 0; i < 8; ++i) { const float send = h5 ? a[i] : a[i + 8]; const float keep = h5 ? a[i + 8] : a[i]; b[i] = keep + __shfl_xor(send, 32); }
#pragma unroll
    for (int i = 0; i < 4; ++i) { const float send = h4 ? b[i] : b[i + 4]; const float keep = h4 ? b[i + 4] : b[i]; c[i] = keep + __shfl_xor(send, 16); }
#pragma unroll
    for (int i = 0; i < 2; ++i) { const float send = h3 ? c[i] : c[i + 2]; const float keep = h3 ? c[i + 2] : c[i]; d[i] = keep + __shfl_xor(send, 8); }
    const float send = h2 ? d[0] : d[1]; const float keep = h2 ? d[1] : d[0]; float e = keep + __shfl_xor(send, 4);
    e += __shfl_xor(e, 2); e += __shfl_xor(e, 1);
    return e;
}
__device__ __forceinline__ float rdlane(float v, int l) { return __uint_as_float((unsigned)__builtin_amdgcn_readlane((int)__float_as_uint(v), l)); }

__device__ __forceinline__ int expert_pstart(const Ctx& F, int layer, int& ntiles_total, int& my_tiles) {
    const unsigned* gcnt = F.ctl + CW_CNT + layer * 16 * 64;
    int c = (F.lane < 16) ? (int)__hip_atomic_load(gcnt + F.lane * 64, __ATOMIC_RELAXED, __HIP_MEMORY_SCOPE_AGENT) : 0;
    const int tiles = (c + 255) >> 8; int incl = tiles;
#pragma unroll
    for (int o = 1; o < 16; o <<= 1) { const int tt = __shfl_up(incl, o); if (F.lane >= o) incl += tt; }
    ntiles_total = __builtin_amdgcn_readlane(incl, 15); my_tiles = tiles;
    return (incl - tiles) * 256;
}
constexpr int LN_WXS = 1028;
constexpr int LN_WX = 0, LN_ROWI = 66048  , LN_ROWG = 66048 + 2048  , LN_CNT = 66048 + 3072  , LN_GATES = 66048 + 4096  ;
__device__ __forceinline__ int ld_i32(const int* p) { return (int)__hip_atomic_load((const unsigned*)p, __ATOMIC_RELAXED, __HIP_MEMORY_SCOPE_AGENT); }
__device__ __forceinline__ float ld_f32(const float* p) { return __uint_as_float(__hip_atomic_load((const unsigned*)p, __ATOMIC_RELAXED, __HIP_MEMORY_SCOPE_AGENT)); }
template <int MODE>
__device__ __forceinline__ void ln_phase(const Ctx& F, const Args& a, int layer) {
    bf16_t* xs = (bf16_t*)(F.ws + WS_XB);
    unsigned char* x8 = (unsigned char*)(F.ws + WS_X8);
    const float* gvec = (MODE == 0 ? a.in[8] : a.in[10]) + layer * D; const float* bvec = (MODE == 0 ? a.in[9] : a.in[11]) + layer * D;
    LAS float* Wx = (LAS float*)(F.lds + LN_WX);
    LAS int* rowi = (LAS int*)(F.lds + LN_ROWI); LAS float* rowg = (LAS float*)(F.lds + LN_ROWG); LAS int* cnt = (LAS int*)(F.lds + LN_CNT);
    LAS float* gates = (LAS float*)(F.lds + LN_GATES);
    const int lane = F.lane;
    f32x4 gv[4], bv[4];
#pragma unroll
    for (int j = 0; j < 4; ++j) { gv[j] = *((const f32x4*)gvec + lane + 64 * j); bv[j] = *((const f32x4*)bvec + lane + 64 * j); }
    if (MODE != 2) {
        const float* W = (MODE == 0) ? a.in[12] : (a.in[4] + 3072); const int ldw = (MODE == 0) ? 16 : 3088;
        for (int i = F.tid; i < 16384; i += NTHREADS) { const int col = i >> 4, e = i & 15; Wx[e * LN_WXS + col] = W[(size_t)col * ldw + e]; }
    }
    const int* tok_e = (const int*)(F.ws + WS_TOK_E); const int* tok_slot = (const int*)(F.ws + WS_TOK_SLOT); const float* tok_gate = (const float*)(F.ws + WS_TOK_GATE);
    int pst = 0; if (MODE != 0) { int nt_, mt_; pst = expert_pstart(F, layer, nt_, mt_); }
    const unsigned char* yb = (const unsigned char*)(F.ws + WS_BUFB);
    for (int rblk = F.bid; rblk < T / 128; rblk += F.G) {
        if (MODE == 0 && F.tid < 32) cnt[F.tid] = 0;
        __syncthreads();
        const int R0 = rblk * 128, W0 = R0 + F.wave * 16;
        int dd0 = 0, dd1 = 0; float gg0 = 0.f, gg1 = 0.f;
        if (MODE != 0) { const int rowl = W0 + (lane & 15); const int ee = ld_i32(tok_e + rowl);
            dd0 = __shfl(pst, ee & 255) + ld_i32(tok_slot + 2 * rowl); dd1 = __shfl(pst, ee >> 8) + ld_i32(tok_slot + 2 * rowl + 1); gg0 = ld_f32(tok_gate + 2 * rowl); gg1 = ld_f32(tok_gate + 2 * rowl + 1); }
        u32x2 nx[2][4]; unsigned ny0[2][4], ny1[2][4];
#define LN_ISSUE(i0) do { _Pragma("unroll") for (int rr = 0; rr < 2; ++rr) { const int row = W0 + (i0) + rr; const u32x2* xr = (const u32x2*)(xs + (size_t)row * D) + lane; \
            _Pragma("unroll") for (int j = 0; j < 4; ++j) nx[rr][j] = xr[64 * j]; \
            if (MODE != 0) { const int d0 = __builtin_amdgcn_readlane(dd0, (i0) + rr), d1 = __builtin_amdgcn_readlane(dd1, (i0) + rr); \
                const unsigned* y0 = (const unsigned*)(yb + (size_t)d0 * D) + lane; const unsigned* y1 = (const unsigned*)(yb + (size_t)d1 * D) + lane; \
                _Pragma("unroll") for (int j = 0; j < 4; ++j) { ny0[rr][j] = y0[64 * j]; ny1[rr][j] = y1[64 * j]; } } } } while (0)
        LN_ISSUE(0);
#pragma unroll 1
        for (int ii = 0; ii < 16; ii += 2) {
            f32x4 v[2][4];
#pragma unroll
            for (int rr = 0; rr < 2; ++rr) {
#pragma unroll
                for (int j = 0; j < 4; ++j) { v[rr][j][0] = bf_lo(nx[rr][j].x); v[rr][j][1] = bf_hi(nx[rr][j].x); v[rr][j][2] = bf_lo(nx[rr][j].y); v[rr][j][3] = bf_hi(nx[rr][j].y); }
                if (MODE != 0) {
                    const float g0 = rdlane(gg0, ii + rr) * (1.0f / SC_Y), g1 = rdlane(gg1, ii + rr) * (1.0f / SC_Y);
#pragma unroll
                    for (int j = 0; j < 4; ++j) { const f32x2 p0 = __builtin_amdgcn_cvt_pk_f32_fp8((int)ny0[rr][j], false), p1 = __builtin_amdgcn_cvt_pk_f32_fp8((int)ny0[rr][j], true);
                        const f32x2 q0 = __builtin_amdgcn_cvt_pk_f32_fp8((int)ny1[rr][j], false), q1 = __builtin_amdgcn_cvt_pk_f32_fp8((int)ny1[rr][j], true);
                        f32x4 f; f[0] = g0 * p0[0] + g1 * q0[0]; f[1] = g0 * p0[1] + g1 * q0[1]; f[2] = g0 * p1[0] + g1 * q1[0]; f[3] = g0 * p1[1] + g1 * q1[1];
                        v[rr][j] = v[rr][j] * ALPHA + f; }
                }
            }
            if (ii + 2 < 16) LN_ISSUE(ii + 2);
#pragma unroll
            for (int rr = 0; rr < 2; ++rr) {
                float s = 0.f;
#pragma unroll
                for (int j = 0; j < 4; ++j) s += (v[rr][j][0] + v[rr][j][1]) + (v[rr][j][2] + v[rr][j][3]);
                const float mean = wave_sum(s) * (1.0f / D); float q = 0.f;
#pragma unroll
                for (int j = 0; j < 4; ++j) { v[rr][j] = v[rr][j] - mean; q += (v[rr][j][0] * v[rr][j][0] + v[rr][j][1] * v[rr][j][1]) + (v[rr][j][2] * v[rr][j][2] + v[rr][j][3] * v[rr][j][3]); }
                const float rstd = 1.0f / sqrtf(wave_sum(q) * (1.0f / D) + LN_EPS);
                const int row = W0 + ii + rr;
                u32x2* bo = (u32x2*)(xs + (size_t)row * D) + lane;
#pragma unroll
                for (int j = 0; j < 4; ++j) { v[rr][j] = v[rr][j] * rstd * gv[j] + bv[j];
                    if (MODE == 2) { ((f32x4*)(a.out + (size_t)row * D))[lane + 64 * j] = v[rr][j]; }
                    else { u32x2 w; w.x = cvt_pk_bf16(v[rr][j][0], v[rr][j][1]); w.y = cvt_pk_bf16(v[rr][j][2], v[rr][j][3]); bo[64 * j] = w; }
                    if (MODE == 0) { ((unsigned*)(x8 + (size_t)row * D))[lane + 64 * j] = pk4_fp8_sat(v[rr][j][0] * SC_X, v[rr][j][1] * SC_X, v[rr][j][2] * SC_X, v[rr][j][3] * SC_X); }
                    if (MODE == 1) { ((unsigned*)(x8 + (size_t)row * D))[lane + 64 * j] = pk4_i8(v[rr][j][0], v[rr][j][1], v[rr][j][2], v[rr][j][3], SI_X); } }
            }
            if (MODE != 2) {
                float acc[2][16];
#pragma unroll
                for (int e = 0; e < 16; ++e) {
                    f32x4 w[4];
#pragma unroll
                    for (int j = 0; j < 4; ++j) w[j] = *((const LAS f32x4*)(Wx + e * LN_WXS) + lane + 64 * j);
#pragma unroll
                    for (int rr = 0; rr < 2; ++rr) { f32x2 s2 = {0.f, 0.f};
#pragma unroll
                        for (int j = 0; j < 4; ++j) { s2 = __builtin_elementwise_fma(__builtin_shufflevector(v[rr][j], v[rr][j], 0, 1), __builtin_shufflevector(w[j], w[j], 0, 1), s2);
                                                      s2 = __builtin_elementwise_fma(__builtin_shufflevector(v[rr][j], v[rr][j], 2, 3), __builtin_shufflevector(w[j], w[j], 2, 3), s2); }
                        acc[rr][e] = s2[0] + s2[1]; }
                    asm volatile("" : "+v"(acc[0][e]), "+v"(acc[1][e]));
                }
#pragma unroll
                for (int rr = 0; rr < 2; ++rr) {
                    const float tot = reduce16(acc[rr], lane);
                    const int rl = F.wave * 16 + ii + rr;
                    if ((lane & 3) == 0) gates[rl * 16 + (lane >> 2)] = tot;
                }
            }
        }
#undef LN_ISSUE
        if (MODE == 0) {
            LDS_WAIT(); asm volatile("" ::: "memory");
            if (lane < 16) {
                const int rl = F.wave * 16 + lane;
                float lg[16];
#pragma unroll
                for (int q = 0; q < 4; ++q) { const f32x4 t4 = *(const LAS f32x4*)(gates + rl * 16 + 4 * q); lg[4 * q] = t4[0]; lg[4 * q + 1] = t4[1]; lg[4 * q + 2] = t4[2]; lg[4 * q + 3] = t4[3]; }
                float mx = lg[0];
#pragma unroll
                for (int e = 1; e < 16; ++e) mx = fmaxf(mx, lg[e]);
                float sum = 0.f;
#pragma unroll
                for (int e = 0; e < 16; ++e) { lg[e] = __expf(lg[e] - mx); sum += lg[e]; }
                const float inv = 1.0f / sum;
                int gbest = 0; float gsbest = -3.0e38f; float w4[4], p4[4];
#pragma unroll
                for (int i = 0; i < 4; ++i) { w4[i] = 0.f; p4[i] = 0.f; }
#pragma unroll
                for (int g = 0; g < 4; ++g) {
                    float pp[4], ss[4];
#pragma unroll
                    for (int i = 0; i < 4; ++i) { pp[i] = lg[4 * g + i] * inv; ss[i] = pp[i] + a.in[13][4 * g + i]; }
                    const float mx1 = fmaxf(fmaxf(ss[0], ss[1]), fmaxf(ss[2], ss[3]));
                    const float a01 = fminf(ss[0], ss[1]), b01 = fmaxf(ss[0], ss[1]), a23 = fminf(ss[2], ss[3]), b23 = fmaxf(ss[2], ss[3]);
                    const float mx2 = fmaxf(fminf(b01, b23), fmaxf(a01, a23));
                    const float gs = mx1 + mx2;
                    const bool better = gs > gsbest;
                    gsbest = better ? gs : gsbest; gbest = better ? g : gbest;
#pragma unroll
                    for (int i = 0; i < 4; ++i) { w4[i] = better ? ss[i] : w4[i]; p4[i] = better ? pp[i] : p4[i]; }
                }
                int i0 = 0; float b0 = w4[0];
#pragma unroll
                for (int i = 1; i < 4; ++i) { const bool bt = w4[i] > b0; b0 = bt ? w4[i] : b0; i0 = bt ? i : i0; }
                int i1 = 0; float b1 = -3.0e38f;
#pragma unroll
                for (int i = 0; i < 4; ++i) { const bool bt = (i != i0) && (w4[i] > b1); b1 = bt ? w4[i] : b1; i1 = bt ? i : i1; }
                const float q0 = i0 == 0 ? p4[0] : i0 == 1 ? p4[1] : i0 == 2 ? p4[2] : p4[3];
                const float q1 = i1 == 0 ? p4[0] : i1 == 1 ? p4[1] : i1 == 2 ? p4[2] : p4[3];
                const float gi = 1.0f / (q0 + q1);
                const int e0 = gbest * 4 + i0, e1 = gbest * 4 + i1;
                const int r0 = __hip_atomic_fetch_add(cnt + e0, 1, __ATOMIC_RELAXED, __HIP_MEMORY_SCOPE_WORKGROUP);
                const int r1 = __hip_atomic_fetch_add(cnt + e1, 1, __ATOMIC_RELAXED, __HIP_MEMORY_SCOPE_WORKGROUP);
                rowi[rl * 4 + 0] = e0; rowi[rl * 4 + 1] = e1; rowi[rl * 4 + 2] = r0; rowi[rl * 4 + 3] = r1;
                rowg[rl * 2 + 0] = q0 * gi; rowg[rl * 2 + 1] = q1 * gi;
            }
        }
        __syncthreads();
        if (MODE == 0) {
            unsigned* gcnt = F.ctl + CW_CNT + layer * 16 * 64;
            if (F.tid < 16) cnt[16 + F.tid] = (int)atomicAdd(gcnt + F.tid * 64, (unsigned)cnt[F.tid]);
            __syncthreads();
            if (F.tid < 128) {
                const int t = R0 + F.tid; const int e0 = rowi[F.tid * 4], e1 = rowi[F.tid * 4 + 1];
                ((int*)(F.ws + WS_TOK_E))[t] = e0 | (e1 << 8);
                const int s0 = cnt[16 + e0] + rowi[F.tid * 4 + 2], s1 = cnt[16 + e1] + rowi[F.tid * 4 + 3];
                ((int*)(F.ws + WS_TOK_SLOT))[2 * t] = s0; ((int*)(F.ws + WS_TOK_SLOT))[2 * t + 1] = s1;
                ((int*)(F.ws + WS_SLOT_TOK))[e0 * 32768 + s0] = t; ((int*)(F.ws + WS_SLOT_TOK))[e1 * 32768 + s1] = t;
                ((float*)(F.ws + WS_TOK_GATE))[2 * t] = rowg[F.tid * 2]; ((float*)(F.ws + WS_TOK_GATE))[2 * t + 1] = rowg[F.tid * 2 + 1];
            }
        }
        if (MODE == 1) {
            const int h = F.wave;
#pragma unroll
            for (int cc = 0; cc < 2; ++cc) {
                const int rl = cc * 64 + lane, t = R0 + rl;
                const float li = gates[rl * 16 + h] + a.in[5][h], fp = gates[rl * 16 + 8 + h] + a.in[5][8 + h];
                const float lf = fminf(fp, 0.f) - log1pf(expf(-fabsf(fp)));
                float b = lf;
#pragma unroll
                for (int o = 1; o < 64; o <<= 1) { const float tt = __shfl_up(b, o); if (lane >= o) b += tt; }
                const float ib = li - b; float cm = ib;
#pragma unroll
                for (int o = 1; o < 64; o <<= 1) { const float tt = __shfl_up(cm, o); if (lane >= o) cm = fmaxf(cm, tt); }
                ((float*)(F.ws + WS_GB))[t * 8 + h] = b; ((float*)(F.ws + WS_GIB))[t * 8 + h] = ib; ((float*)(F.ws + WS_GCM))[t * 8 + h] = cm;
                if (lane == 63) { const int bb = t / SEQ, c = (t % SEQ) / 64; f32x2 st; st.x = b; st.y = cm; ((f32x2*)(F.ws + WS_CHST))[(bb * 8 + h) * 64 + c] = st; }
            }
        }
        __syncthreads();
    }
}

__device__ __forceinline__ int build_tile_table(const Ctx& F, int layer) {
    int nt, mt; const int pstart = expert_pstart(F, layer, nt, mt);
    LAS unsigned char* te = F.lds + TILE_E_OFF;
    if (F.wave == 0 && F.lane < 16) { const int t0 = pstart >> 8; for (int i = 0; i < mt; ++i) te[t0 + i] = (unsigned char)F.lane;
        LAS int* ti = (LAS int*)(F.lds + TINFO_OFF); ti[F.lane] = t0; ti[16 + F.lane] = (int)__hip_atomic_load(F.ctl + CW_CNT + layer * 16 * 64 + F.lane * 64, __ATOMIC_RELAXED, __HIP_MEMORY_SCOPE_AGENT); }
    __syncthreads();
    return nt;
}

__device__ __forceinline__ int offv_d(int row, int ch) { return 256 * row + 16 * (ch ^ (((row & 3) << 2) | (((row >> 2) & 1) << 1) | ((row >> 3) & 1))); }
__device__ __forceinline__ int offk_b(int row, int ch) { return 128 * row + 16 * (ch ^ ((((row >> 1) & 1) << 1) | (((row >> 3) & 1) << 2))); }
__device__ __forceinline__ int offv_b(int row, int ch) { return 256 * row + 16 * (ch ^ (((row & 3) << 2) | ((row >> 2) & 3))); }
constexpr int M6_MST = MISC_OFF + 1024  , M6_CH = MISC_OFF + 1152  , M6_OFF = MISC_OFF + 1664  , M6_PM = MISC_OFF + 1920  ,
              M6_BL = MISC_OFF + 2176  , M6_CML = MISC_OFF + 2240  ;
__device__ __forceinline__ void ml256_setup(const Ctx& F, int bh) {
    LAS float* mst = (LAS float*)(F.lds + M6_MST); LAS f32x2* ch = (LAS f32x2*)(F.lds + M6_CH); LAS float* offs = (LAS float*)(F.lds + M6_OFF); LAS float* pms = (LAS float*)(F.lds + M6_PM);
    LAS float* bl = (LAS float*)(F.lds + M6_BL); LAS float* cml = (LAS float*)(F.lds + M6_CML);
    __syncthreads();
    if (F.wave == 0) {
        const int lane = F.lane, sub = lane & 3, base = lane & ~3;
        const f32x2 st = ((const f32x2*)(F.ws + WS_CHST))[bh * 64 + lane]; ch[lane] = st;
        float off = 0.f, pm = -3.0e38f;
#pragma unroll
        for (int q = 0; q < 3; ++q) { const float bq = __shfl(st.x, base + q), cq = __shfl(st.y, base + q); if (q < sub) { pm = fmaxf(pm, cq - off); off += bq; } }
        offs[lane] = off; pms[lane] = pm;
        const float b256 = off + st.x, c256 = fmaxf(pm, st.y - off);
        if (sub == 3) { bl[lane >> 2] = b256; cml[lane >> 2] = c256; }
        float A = __shfl(b256, 4 * (lane & 15) + 3), B = A + __shfl(c256, 4 * (lane & 15) + 3);
#pragma unroll
        for (int o = 1; o < 16; o <<= 1) { const float Ap = __shfl_up(A, o), Bp = __shfl_up(B, o); if ((lane & 15) >= o) { B = fmaxf(Bp + A, B); A = Ap + A; } }
        if (lane < 16) { mst[lane + 1] = fmaxf(A, B); if (lane == 0) mst[0] = 0.f; }
    }
    __syncthreads();
}
__device__ __forceinline__ void ml_stage_b256(const Ctx& F) {
    const bf16_t* proj = (const bf16_t*)(F.ws + WS_BUFC); bf16_t* Dc = (bf16_t*)(F.ws + WS_BUFB); float* Dn = (float*)(F.ws + WS_DN);
    const float* gib = (const float*)(F.ws + WS_GIB);
    LAS float* mst = (LAS float*)(F.lds + M6_MST); LAS float* offs = (LAS float*)(F.lds + M6_OFF); LAS float* cml = (LAS float*)(F.lds + M6_CML);
    const int lane = F.lane, fr = lane & 15, fq = lane >> 4, w = F.wave, pr = w >> 1, wh = w & 1, pt = wh * 64 + lane;
    LAS unsigned char* vimg = F.lds + pr * 32768; LAS unsigned char* kimg = vimg + 16384;
    const int tq = fr >> 2, tp1 = (fr & 3) >> 1, tb = 8 * (fr & 1);
    for (int grp = F.bid; grp < 256; grp += F.G) {
        const int bh = grp >> 2, bb = bh >> 3, h = bh & 7, C6 = 4 * (grp & 3) + pr;
        ml256_setup(F, bh);
        const float Ml = fmaxf(mst[C6], cml[C6]);
        f32x4 acc[4][4], accn[4];
#pragma unroll
        for (int a = 0; a < 4; ++a) { accn[a] = (f32x4){0.f, 0.f, 0.f, 0.f};
#pragma unroll
            for (int b = 0; b < 4; ++b) acc[a][b] = (f32x4){0.f, 0.f, 0.f, 0.f}; }
        u32x2 vreg[8]; u32x4 kreg[4]; float gr[4];
#define B6_ISSUE(itn) do { const int t0n = bb * SEQ + (4 * C6 + (itn)) * 64; \
            _Pragma("unroll") for (int i = 0; i < 8; ++i) { const int idx = pt + 128 * i; vreg[i] = *(const u32x2*)(F.ws + WS_V8 + (size_t)(t0n + (idx >> 4)) * 1024 + h * 128 + 8 * (idx & 15)); } \
            _Pragma("unroll") for (int i = 0; i < 4; ++i) { const int idx = pt + 128 * i; kreg[i] = *(const u32x4*)(proj + (size_t)(t0n + (idx >> 3)) * 3072 + 512 + h * 64 + 8 * (idx & 7)); gr[i] = gib[(size_t)(t0n + (idx >> 3)) * 8 + h]; } } while (0)
        B6_ISSUE(0);
#pragma unroll 1
        for (int it = 0; it < 4; ++it) {
            const int c = 4 * C6 + it;
            __syncthreads();
            const float sh = offs[c] + Ml;
#pragma unroll
            for (int i = 0; i < 8; ++i) { const int idx = pt + 128 * i; *(LAS u32x4*)(vimg + offv_b(idx >> 4, idx & 15)) = u8x8_bf16(vreg[i], 1.0f / SV8); }
#pragma unroll
            for (int i = 0; i < 4; ++i) { const int idx = pt + 128 * i; const float g = __expf(gr[i] - sh); u32x4 o;
#pragma unroll
                for (int q = 0; q < 4; ++q) o[q] = cvt_pk_bf16(bf_lo(kreg[i][q]) * g, bf_hi(kreg[i][q]) * g);
                *(LAS u32x4*)(kimg + offk_b(idx >> 3, idx & 7)) = o; }
            __syncthreads();
            if (it + 1 < 4) B6_ISSUE(it + 1);
#pragma unroll
            for (int th = 0; th < 2; ++th) {
                bf16x8 ka[2][2];
#pragma unroll
                for (int t2 = 0; t2 < 2; ++t2)
#pragma unroll
                    for (int s2 = 0; s2 < 2; ++s2) { const int td = 2 * th + t2, row = 32 * s2 + 8 * fq + tq;
                        const s16x4 lo = __builtin_amdgcn_ds_read_tr16_b64_v4i16((LAS s16x4*)(kimg + offk_b(row, 2 * td + tp1) + tb));
                        const s16x4 hi = __builtin_amdgcn_ds_read_tr16_b64_v4i16((LAS s16x4*)(kimg + offk_b(row + 4, 2 * td + tp1) + tb));
                        ka[t2][s2] = __builtin_shufflevector(lo, hi, 0, 1, 2, 3, 4, 5, 6, 7); }
#pragma unroll
                for (int tvl = 0; tvl < 4; ++tvl) { const int tv = 4 * wh + tvl;
                    bf16x8 vb[2];
#pragma unroll
                    for (int s2 = 0; s2 < 2; ++s2) { const int row = 32 * s2 + 8 * fq + tq;
                        const s16x4 lo = __builtin_amdgcn_ds_read_tr16_b64_v4i16((LAS s16x4*)(vimg + offv_b(row, 2 * tv + tp1) + tb));
                        const s16x4 hi = __builtin_amdgcn_ds_read_tr16_b64_v4i16((LAS s16x4*)(vimg + offv_b(row + 4, 2 * tv + tp1) + tb));
                        vb[s2] = __builtin_shufflevector(lo, hi, 0, 1, 2, 3, 4, 5, 6, 7); }
#pragma unroll
                    for (int t2 = 0; t2 < 2; ++t2)
#pragma unroll
                        for (int s2 = 0; s2 < 2; ++s2) acc[tvl][2 * th + t2] = __builtin_amdgcn_mfma_f32_16x16x32_bf16(ka[t2][s2], vb[s2], acc[tvl][2 * th + t2], 0, 0, 0);
                }
                if (wh == 0) {
                    const short one = (fr == 0) ? (short)0x3F80 : (short)0; const bf16x8 ones = {one, one, one, one, one, one, one, one};
#pragma unroll
                    for (int t2 = 0; t2 < 2; ++t2)
#pragma unroll
                        for (int s2 = 0; s2 < 2; ++s2) accn[2 * th + t2] = __builtin_amdgcn_mfma_f32_16x16x32_bf16(ka[t2][s2], ones, accn[2 * th + t2], 0, 0, 0);
                }
            }
        }
#undef B6_ISSUE
        bf16_t* dst = Dc + ((size_t)(bh * 16 + C6) * 8192);
#pragma unroll
        for (int tvl = 0; tvl < 4; ++tvl)
#pragma unroll
            for (int td = 0; td < 4; ++td) { const int tv = 4 * wh + tvl; u32x2 wv; wv.x = cvt_pk_bf16_c(acc[tvl][td][0], acc[tvl][td][1]); wv.y = cvt_pk_bf16_c(acc[tvl][td][2], acc[tvl][td][3]);
                *(u32x2*)(dst + (16 * tv + fr) * 64 + 16 * td + 4 * fq) = wv; }
        if (wh == 0 && fr == 0) {
#pragma unroll
            for (int td = 0; td < 4; ++td) *(f32x4*)(Dn + (size_t)(bh * 16 + C6) * 64 + 16 * td + 4 * fq) = accn[td];
        }
    }
}
__device__ __forceinline__ void ml_stage_c256(const Ctx& F) {
    const u32x2* Dc = (const u32x2*)(F.ws + WS_BUFB); u32x2* Cst = (u32x2*)(F.ws + WS_CST);
    const f32x4* Dn = (const f32x4*)(F.ws + WS_DN); f32x4* Nst = (f32x4*)(F.ws + WS_NST);
    LAS float* mst = (LAS float*)(F.lds + M6_MST); LAS float* cml = (LAS float*)(F.lds + M6_CML);
    for (int grp = F.bid; grp < 256; grp += F.G) {
        const int bh = grp >> 2, idx = (grp & 3) * 512 + F.tid;
        ml256_setup(F, bh);
        const bool ncarry = ((grp & 3) == 0) && F.tid < 16;
        f32x4 st = (f32x4){0.f, 0.f, 0.f, 0.f}, sn = st;
        f32x4 d[16], dn[16];
#pragma unroll
        for (int i = 0; i < 16; ++i) { const u32x2 dw = Dc[(size_t)(bh * 16 + i) * 2048 + idx]; d[i] = (f32x4){bf_lo(dw.x), bf_hi(dw.x), bf_lo(dw.y), bf_hi(dw.y)}; if (ncarry) dn[i] = Dn[(size_t)(bh * 16 + i) * 16 + F.tid]; }
#pragma unroll
        for (int i = 0; i < 16; ++i) { const float m = mst[i]; const float gs = __expf(m - fmaxf(m, cml[i]));
            u32x2 wv; wv.x = cvt_pk_bf16(st[0], st[1]); wv.y = cvt_pk_bf16(st[2], st[3]); Cst[(size_t)(bh * 16 + i) * 2048 + idx] = wv;
            st = st * gs + d[i];
            if (ncarry) { Nst[(size_t)(bh * 16 + i) * 16 + F.tid] = sn; sn = sn * gs + dn[i]; } }
    }
}
constexpr int D6_V = 0  , D6_K = 65536  , D6_C = 98304  ,
              D6_IB = 114688  , D6_CM = 115712, D6_BB = 116736, D6_NS = 117760  , D6_ST = 118784  ;
__device__ __forceinline__ void ml_stage_d256(const Ctx& F, const float* norm_g) {
    const bf16_t* proj = (const bf16_t*)(F.ws + WS_BUFC); const bf16_t* Cst = (const bf16_t*)(F.ws + WS_CST); const float* Nst = (const float*)(F.ws + WS_NST);
    unsigned char* hmix8 = (unsigned char*)(F.ws + WS_HMIX);
    const float* gib = (const float*)(F.ws + WS_GIB); const float* gcm = (const float*)(F.ws + WS_GCM); const float* gb = (const float*)(F.ws + WS_GB);
    LAS float* mst = (LAS float*)(F.lds + M6_MST); LAS float* offs = (LAS float*)(F.lds + M6_OFF); LAS float* pms = (LAS float*)(F.lds + M6_PM);
    LAS float* ibs = (LAS float*)(F.lds + D6_IB); LAS float* cms = (LAS float*)(F.lds + D6_CM); LAS float* bbs = (LAS float*)(F.lds + D6_BB); LAS float* ns = (LAS float*)(F.lds + D6_NS);
    LAS unsigned char* vt = F.lds + D6_V; LAS unsigned char* kimg = F.lds + D6_K; LAS unsigned char* csl = F.lds + D6_C;
    const int lane = F.lane, fr = lane & 15, fq = lane >> 4, w = F.wave, tid = F.tid;
    LAS unsigned char* stg = F.lds + D6_ST + w * 4224;
#ifndef D6_REPS
#define D6_REPS 1
#endif
#pragma unroll 1
    for (int rep_ = 0; rep_ < D6_REPS; ++rep_)
    for (int grp = F.bid; grp < 256; grp += F.G) {
        const int bh = grp >> 2, bb = bh >> 3, h = bh & 7;
        ml256_setup(F, bh);
        u32x2 vreg[8]; u32x4 kreg[4], creg[2]; float s_ib = 0.f, s_cm = 0.f, s_bb = 0.f, s_ns = 0.f;
#define D6_ISSUE(itn) do { const int C6n = 4 * (grp & 3) + (itn), t0n = bb * SEQ + C6n * 256; const bf16_t* csn = Cst + (size_t)(bh * 16 + C6n) * 8192; \
            _Pragma("unroll") for (int i = 0; i < 8; ++i) { const int idx = tid + 512 * i; vreg[i] = *(const u32x2*)(F.ws + WS_V8 + (size_t)(t0n + (idx >> 4)) * 1024 + h * 128 + 8 * (idx & 15)); } \
            _Pragma("unroll") for (int i = 0; i < 4; ++i) { const int idx = tid + 512 * i; kreg[i] = *(const u32x4*)(proj + (size_t)(t0n + (idx >> 3)) * 3072 + 512 + h * 64 + 8 * (idx & 7)); } \
            _Pragma("unroll") for (int i = 0; i < 2; ++i) { const int idx = tid + 512 * i; creg[i] = *(const u32x4*)(csn + (size_t)(idx >> 3) * 64 + 8 * (idx & 7)); } \
            if (tid < 256) { s_ib = gib[(size_t)(t0n + tid) * 8 + h]; s_cm = gcm[(size_t)(t0n + tid) * 8 + h]; s_bb = gb[(size_t)(t0n + tid) * 8 + h]; } \
            if (tid < 64) s_ns = Nst[(size_t)(bh * 16 + C6n) * 64 + tid]; } while (0)
        D6_ISSUE(0);
#pragma unroll 1
        for (int it = 0; it < 4; ++it) {
            const int C6 = 4 * (grp & 3) + it, t0 = bb * SEQ + C6 * 256;
            __syncthreads();
#pragma unroll
            for (int i = 0; i < 8; ++i) { const int idx = tid + 512 * i; *(LAS u32x4*)(vt + offv_d(idx >> 4, idx & 15)) = u8x8_bf16(vreg[i], 1.0f / SV8); }
#pragma unroll
            for (int i = 0; i < 4; ++i) { const int idx = tid + 512 * i; *(LAS u32x4*)(kimg + pg8::lds_byte(idx >> 3, 8 * (idx & 7))) = kreg[i]; }
#pragma unroll
            for (int i = 0; i < 2; ++i) { const int idx = tid + 512 * i; *(LAS u32x4*)(csl + pg8::lds_byte(idx >> 3, 8 * (idx & 7))) = creg[i]; }
            if (tid < 256) { const int c64 = 4 * C6 + (tid >> 6); const float off = offs[c64], pm = pms[c64]; ibs[tid] = s_ib - off; cms[tid] = fmaxf(pm, s_cm - off); bbs[tid] = s_bb + off; }
            if (tid < 64) ns[tid] = s_ns;
            __syncthreads();
            if (it + 1 < 4) D6_ISSUE(it + 1);
            const float mc = mst[C6];
#pragma unroll 1
            for (int pass = 0; pass < 2; ++pass) {
                const int tl = pass ? 15 - w : w, l = 16 * tl + fr;
                bf16x8 qc[2];
#pragma unroll
                for (int s2 = 0; s2 < 2; ++s2) qc[s2] = *(const bf16x8*)(proj + (size_t)(t0 + l) * 3072 + h * 64 + 32 * s2 + 8 * fq);
                u32x2 opre[4];
#pragma unroll
                for (int k = 0; k < 4; ++k) opre[k] = *(const u32x2*)(F.ws + WS_O8 + (size_t)(t0 + 16 * tl + 4 * k + fq) * 1024 + h * 128 + 8 * fr);
                const float Mrow = fmaxf(mc, cms[l]);
                const float wint = __expf(mc - Mrow);
                f32x4 an[8];
#pragma unroll
                for (int tv = 0; tv < 8; ++tv) an[tv] = (f32x4){0.f, 0.f, 0.f, 0.f};
                float rsum = 0.f;
#pragma unroll 1
                for (int kk = 0; kk <= (tl >> 1); ++kk) {
                    f32x4 sa[2];
#pragma unroll
                    for (int u = 0; u < 2; ++u) { sa[u] = (f32x4){0.f, 0.f, 0.f, 0.f}; const int tr = 2 * kk + u;
#pragma unroll
                        for (int s2 = 0; s2 < 2; ++s2) { const bf16x8 kf = *(const LAS bf16x8*)(kimg + pg8::lds_byte(16 * tr + fr, 32 * s2 + 8 * fq));
                            sa[u] = __builtin_amdgcn_mfma_f32_16x16x32_bf16(kf, qc[s2], sa[u], 0, 0, 0); }
                        const f32x4 ibv = *(const LAS f32x4*)(ibs + 16 * tr + 4 * fq);
#pragma unroll
                        for (int j = 0; j < 4; ++j) { const int r = 16 * tr + 4 * fq + j; const float p = (r <= l) ? __expf(ibv[j] - Mrow) : 0.f; const float av = p * sa[u][j]; sa[u][j] = av; rsum += av; } }
                    u32x4 pk; pk.x = cvt_pk_bf16(sa[0][0], sa[0][1]); pk.y = cvt_pk_bf16(sa[0][2], sa[0][3]); pk.z = cvt_pk_bf16(sa[1][0], sa[1][1]); pk.w = cvt_pk_bf16(sa[1][2], sa[1][3]);
                    const bf16x8 af = __builtin_bit_cast(bf16x8, pk);
                    const int trow = 32 * kk + 4 * fq + (fr >> 2), tb = 8 * (fr & 1);
#pragma unroll
                    for (int tv = 0; tv < 8; ++tv) { const int tch = 2 * tv + ((fr & 3) >> 1);
                        const s16x4 lo = __builtin_amdgcn_ds_read_tr16_b64_v4i16((LAS s16x4*)(vt + offv_d(trow, tch) + tb));
                        const s16x4 hi = __builtin_amdgcn_ds_read_tr16_b64_v4i16((LAS s16x4*)(vt + offv_d(trow + 16, tch) + tb));
                        const bf16x8 vf = __builtin_shufflevector(lo, hi, 0, 1, 2, 3, 4, 5, 6, 7);
                        an[tv] = __builtin_amdgcn_mfma_f32_16x16x32_bf16(vf, af, an[tv], 0, 0, 0); }
                }
                rsum += __shfl_xor(rsum, 16); rsum += __shfl_xor(rsum, 32);
                float qn = 0.f;
#pragma unroll
                for (int s2 = 0; s2 < 2; ++s2) { const f32x4 n0 = *(const LAS f32x4*)(ns + 32 * s2 + 8 * fq), n1 = *(const LAS f32x4*)(ns + 32 * s2 + 8 * fq + 4);
                    const u32x4 qw = __builtin_bit_cast(u32x4, qc[s2]);
                    qn += bf_lo(qw[0]) * n0[0] + bf_hi(qw[0]) * n0[1] + bf_lo(qw[1]) * n0[2] + bf_hi(qw[1]) * n0[3] + bf_lo(qw[2]) * n1[0] + bf_hi(qw[2]) * n1[1] + bf_lo(qw[3]) * n1[2] + bf_hi(qw[3]) * n1[3]; }
                qn += __shfl_xor(qn, 16); qn += __shfl_xor(qn, 32);
                const float den = rsum + wint * qn;
                const float mt = bbs[l] + Mrow;
                const float rden = __builtin_amdgcn_rcpf(fmaxf(fabsf(den), __expf(-mt)));
                unsigned hp[8][2]; float sq = 0.f;
#pragma unroll
                for (int tv = 0; tv < 8; ++tv) {
                    f32x4 ac = (f32x4){0.f, 0.f, 0.f, 0.f};
#pragma unroll
                    for (int s2 = 0; s2 < 2; ++s2) { const bf16x8 cf = *(const LAS bf16x8*)(csl + pg8::lds_byte(16 * tv + fr, 32 * s2 + 8 * fq));
                        ac = __builtin_amdgcn_mfma_f32_16x16x32_bf16(cf, qc[s2], ac, 0, 0, 0); }
                    float hh[4];
#pragma unroll
                    for (int j = 0; j < 4; ++j) { hh[j] = (an[tv][j] + wint * ac[j]) * rden; sq += hh[j] * hh[j]; }
                    hp[tv][0] = cvt_pk_bf16(hh[0], hh[1]); hp[tv][1] = cvt_pk_bf16(hh[2], hh[3]);
                }
                sq += __shfl_xor(sq, 16); sq += __shfl_xor(sq, 32);
                const float rn = __builtin_amdgcn_rsqf(sq * (1.0f / 128.0f) + HN_EPS);
#pragma unroll
                for (int tv = 0; tv < 8; ++tv) { u32x2 wv; wv.x = cvt_pk_bf16(bf_lo(hp[tv][0]) * rn, bf_hi(hp[tv][0]) * rn); wv.y = cvt_pk_bf16(bf_lo(hp[tv][1]) * rn, bf_hi(hp[tv][1]) * rn);
                    *(LAS u32x2*)(stg + fr * 264 + (16 * tv + 4 * fq) * 2) = wv; }
                const f32x4 ng0 = *(const f32x4*)(norm_g + h * 128 + 8 * fr), ng1 = *(const f32x4*)(norm_g + h * 128 + 8 * fr + 4);
                LDS_WAIT(); asm volatile("" ::: "memory");
#pragma unroll
                for (int k = 0; k < 4; ++k) { const int row = 4 * k + fq;
                    const u32x2 h0 = *(const LAS u32x2*)(stg + row * 264 + 16 * fr), h1 = *(const LAS u32x2*)(stg + row * 264 + 16 * fr + 8);
                    const u32x2 op = opre[k]; constexpr float oi = 1.0f / SO8, oo = -128.0f / SO8;
#define D6_SG(w_, k_) __builtin_amdgcn_rcpf(1.0f + __expf(-__builtin_fmaf(ubf(w_, k_), oi, oo)))
                    const float f0 = bf_lo(h0.x) * ng0[0] * D6_SG(op.x, 0), f1 = bf_hi(h0.x) * ng0[1] * D6_SG(op.x, 1);
                    const float f2 = bf_lo(h0.y) * ng0[2] * D6_SG(op.x, 2), f3 = bf_hi(h0.y) * ng0[3] * D6_SG(op.x, 3);
                    const float f4 = bf_lo(h1.x) * ng1[0] * D6_SG(op.y, 0), f5 = bf_hi(h1.x) * ng1[1] * D6_SG(op.y, 1);
                    const float f6 = bf_lo(h1.y) * ng1[2] * D6_SG(op.y, 2), f7 = bf_hi(h1.y) * ng1[3] * D6_SG(op.y, 3);
#undef D6_SG
                    u32x2 o8; o8.x = pk4_fp8_sat(f0 * SC_X, f1 * SC_X, f2 * SC_X, f3 * SC_X); o8.y = pk4_fp8_sat(f4 * SC_X, f5 * SC_X, f6 * SC_X, f7 * SC_X);
                    *(u32x2*)(hmix8 + (size_t)(t0 + 16 * tl + row) * D + h * 128 + 8 * fr) = o8; }
                LDS_WAIT(); asm volatile("" ::: "memory");
            }
        }
        __syncthreads();
    }
#undef D6_ISSUE
}

constexpr int N_PHASES = 19;
__global__ void __launch_bounds__(NTHREADS, 2) fwd_kernel(Args args) {
    extern __shared__ __attribute__((aligned(16))) unsigned char lds_raw[];
    Ctx F;
    F.lds = (LAS unsigned char*)lds_raw; F.ws = args.ws; F.ctl = (unsigned*)(args.ws + WS_CTL);
    F.tid = threadIdx.x; F.lane = F.tid & 63; F.wave = __builtin_amdgcn_readfirstlane(F.tid >> 6); F.G = gridDim.x; F.bid = blockIdx.x;
#define FRESH() do { int l_; asm volatile("v_mbcnt_lo_u32_b32 %0, -1, 0\n\tv_mbcnt_hi_u32_b32 %0, -1, %0" : "=v"(l_)); F.lane = l_; F.tid = F.wave * 64 + l_; } while (0)
    volatile LAS unsigned* MISC = (volatile LAS unsigned*)(F.lds + MISC_OFF);
    if (F.tid < 16) MISC[F.tid] = 0u;
    __syncthreads();
#if MK_PER_PHASE
    XcdBarrier bar; bar.bar = nullptr; bar.x = 0; bar.st = nullptr;
#define GRID_BAR() do { } while (0)
#else
    XcdBarrier bar = xcd_barrier_post(F.ctl + CW_BAR, MISC);
#define GRID_BAR() xcd_barrier(bar)
#endif
    const int lo = args.ph_lo, hi = args.ph_hi;
#ifdef PH_ONLY
#define IN(k) ((k) == PH_ONLY && lo <= (k) && (k) < hi)
#else
#define IN(k) (lo <= (k) && (k) < hi)
#endif
#define SEAM2(k, k2) do { if (IN(k) && IN(k2)) GRID_BAR(); } while (0)
#define SEAM(k) SEAM2(k, (k) + 1)
    bf16_t* const XB = (bf16_t*)(F.ws + WS_XB); bf16_t* const BUFB = (bf16_t*)(F.ws + WS_BUFB); bf16_t* const BUFC = (bf16_t*)(F.ws + WS_BUFC);

    if (IN(0)) { FRESH(); { p0_prologue(F, args); } if (REP_MASK >> 0 & 1) { GRID_BAR(); { p0_prologue(F, args); } } } SEAM(0);
    if (IN(1)) { FRESH(); pg8::Gemm g{XB, (const bf16_t*)(F.ws + WS_WC1), 1024, 0, F.lds + TILE_E_OFF, 0}; pg8::StaticOrder S; S.init(T / 256, 8, F.G, F.bid);
        pg8::EpiMul E{BUFB}; pg8::gemm_phase<pg8::EpiMul>(F.lds, g, S, E, F.wave); if (REP_MASK >> 1 & 1) { GRID_BAR(); pg8::gemm_phase<pg8::EpiMul>(F.lds, g, S, E, F.wave); } } SEAM(1);
    if (IN(2)) { FRESH(); pg8::Gemm g{XB, (const bf16_t*)(F.ws + WS_WC1) + (size_t)2048 * 1024, 1024, 0, F.lds + TILE_E_OFF, 0}; pg8::StaticOrder S; S.init(T / 256, 4, F.G, F.bid);
        pg8::EpiConvGate E{BUFB, args.in[2], BUFB + (size_t)T * D}; pg8::gemm_phase<pg8::EpiConvGate>(F.lds, g, S, E, F.wave); if (REP_MASK >> 2 & 1) { GRID_BAR(); pg8::gemm_phase<pg8::EpiConvGate>(F.lds, g, S, E, F.wave); } } SEAM(2);
    if (IN(3)) { FRESH(); pg8::Gemm g{BUFB + (size_t)T * D, (const bf16_t*)(F.ws + WS_WC2), 1024, 0, F.lds + TILE_E_OFF, 0}; pg8::StaticOrder S; S.init(T / 256, 4, F.G, F.bid);
        pg8::EpiResBf16 E{XB, ALPHA}; pg8::gemm_phase<pg8::EpiResBf16>(F.lds, g, S, E, F.wave); } SEAM(3);
    if (IN(4)) { FRESH(); { ln_phase<0>(F, args, 0); } if (REP_MASK >> 4 & 1) { GRID_BAR(); { ln_phase<0>(F, args, 0); } } } SEAM2(4, 6);
    if (IN(6)) { FRESH(); const int nt = build_tile_table(F, 0); pg8::Gemm g{(const bf16_t*)(F.ws + WS_X8), (const bf16_t*)(F.ws + WS_W13), 512, 1, F.lds + TILE_E_OFF, (size_t)3072 * 512, (const int*)(F.ws + WS_SLOT_TOK), (const LAS int*)(F.lds + TINFO_OFF), (LAS int*)(F.lds + GTAB_OFF)}; pg8::StaticOrder S; S.init(nt, 12, F.G, F.bid);
        pg8::EpiSwiGLU8 E{(unsigned char*)BUFC}; pg8::gemm_phase<pg8::EpiSwiGLU8, true, true, true>(F.lds, g, S, E, F.wave); if (REP_MASK >> 6 & 1) { GRID_BAR(); pg8::gemm_phase<pg8::EpiSwiGLU8, true, true, true>(F.lds, g, S, E, F.wave); } } SEAM(6);
    if (IN(7)) { FRESH(); const int nt = build_tile_table(F, 0); pg8::Gemm g{BUFC, (const bf16_t*)(F.ws + WS_W2), 768, 1, F.lds + TILE_E_OFF, (size_t)1024 * 768}; pg8::StaticOrder S; S.init(nt, 4, F.G, F.bid);
        pg8::EpiFp8S E{(unsigned char*)BUFB, SC_INV * SC_Y}; pg8::gemm_phase<pg8::EpiFp8S, true>(F.lds, g, S, E, F.wave); if (REP_MASK >> 7 & 1) { GRID_BAR(); pg8::gemm_phase<pg8::EpiFp8S, true>(F.lds, g, S, E, F.wave); } } SEAM(7);
    if (IN(8)) { FRESH(); { ln_phase<1>(F, args, 0); } if (REP_MASK >> 8 & 1) { GRID_BAR(); { ln_phase<1>(F, args, 0); } } } SEAM(8);
    if (IN(9)) { FRESH();
        pg8::Gemm g{(const bf16_t*)(F.ws + WS_X8), (const bf16_t*)(F.ws + WS_WM1I8), 512, 0, F.lds + TILE_E_OFF, 0}; pg8::StaticOrder S; S.init(T / 256, 12, F.G, F.bid);
        pg8::EpiBf16SI8 E{BUFC, 3072, F.ws + WS_V8, F.ws + WS_O8}; pg8::gemm_phase<pg8::EpiBf16SI8, false, true, false, true>(F.lds, g, S, E, F.wave); } SEAM(9);
    if (IN(10)) { FRESH(); { ml_stage_b256(F); } if (REP_MASK >> 10 & 1) { GRID_BAR(); { ml_stage_b256(F); } } } SEAM(10);
    if (IN(11)) { FRESH(); { ml_stage_c256(F); } if (REP_MASK >> 11 & 1) { GRID_BAR(); { ml_stage_c256(F); } } } SEAM(11);
    if (IN(12)) { FRESH(); { ml_stage_d256(F, args.in[6]); } if (REP_MASK >> 12 & 1) { GRID_BAR(); { ml_stage_d256(F, args.in[6]); } } } SEAM(12);
    if (IN(13)) { FRESH(); pg8::Gemm g{(const bf16_t*)(F.ws + WS_HMIX), (const bf16_t*)(F.ws + WS_WM2F8), 512, 0, F.lds + TILE_E_OFF, 0}; pg8::StaticOrder S; S.init(T / 256, 4, F.G, F.bid);
        pg8::EpiResBf16 E{XB, ALPHA, SC_INV}; pg8::gemm_phase<pg8::EpiResBf16, true>(F.lds, g, S, E, F.wave); } SEAM(13);
    if (IN(14)) { FRESH(); { ln_phase<0>(F, args, 1); } if (REP_MASK >> 14 & 1) { GRID_BAR(); { ln_phase<0>(F, args, 1); } } } SEAM2(14, 16);
    if (IN(16)) { FRESH(); const int nt = build_tile_table(F, 1); pg8::Gemm g{(const bf16_t*)(F.ws + WS_X8), (const bf16_t*)(F.ws + WS_W13) + (size_t)16 * 3072 * 512, 512, 1, F.lds + TILE_E_OFF, (size_t)3072 * 512, (const int*)(F.ws + WS_SLOT_TOK), (const LAS int*)(F.lds + TINFO_OFF), (LAS int*)(F.lds + GTAB_OFF)}; pg8::StaticOrder S; S.init(nt, 12, F.G, F.bid);
        pg8::EpiSwiGLU8 E{(unsigned char*)BUFC}; pg8::gemm_phase<pg8::EpiSwiGLU8, true, true, true>(F.lds, g, S, E, F.wave); if (REP_MASK >> 16 & 1) { GRID_BAR(); pg8::gemm_phase<pg8::EpiSwiGLU8, true, true, true>(F.lds, g, S, E, F.wave); } } SEAM(16);
    if (IN(17)) { FRESH(); const int nt = build_tile_table(F, 1); pg8::Gemm g{BUFC, (const bf16_t*)(F.ws + WS_W2) + (size_t)16 * 1024 * 768, 768, 1, F.lds + TILE_E_OFF, (size_t)1024 * 768}; pg8::StaticOrder S; S.init(nt, 4, F.G, F.bid);
        pg8::EpiFp8S E{(unsigned char*)BUFB, SC_INV * SC_Y}; pg8::gemm_phase<pg8::EpiFp8S, true>(F.lds, g, S, E, F.wave); if (REP_MASK >> 17 & 1) { GRID_BAR(); pg8::gemm_phase<pg8::EpiFp8S, true>(F.lds, g, S, E, F.wave); } } SEAM(17);
    if (IN(18)) { FRESH(); { ln_phase<2>(F, args, 1); } if (REP_MASK >> 18 & 1) { GRID_BAR(); { ln_phase<2>(F, args, 1); } } }
#undef IN
#undef SEAM
#undef SEAM2
}

extern "C" void kernel_launch(void* const* d_in, const int* in_sizes, int n_in, void* d_out, int out_size, void* d_ws, size_t ws_size, hipStream_t stream) {
    static int grid = 0;
    if (grid == 0) {
        if (n_in != 17 || out_size != T * D || ws_size < WS_END) { fprintf(stderr, "kernel_launch: unexpected shapes (n_in %d, out %d, ws %zu)\n", n_in, out_size, ws_size); grid = -1; return; }
        int dev = 0, cus = 0;
        if (hipGetDevice(&dev) != hipSuccess || hipDeviceGetAttribute(&cus, hipDeviceAttributeMultiprocessorCount, dev) != hipSuccess) { grid = -1; return; }
        if (hipFuncSetAttribute((const void*)fwd_kernel, hipFuncAttributeMaxDynamicSharedMemorySize, LDS_BYTES) != hipSuccess) { fprintf(stderr, "kernel_launch: hipFuncSetAttribute failed\n"); grid = -1; return; }
        int per_cu = 0;
        if (hipOccupancyMaxActiveBlocksPerMultiprocessor(&per_cu, (const void*)fwd_kernel, NTHREADS, LDS_BYTES) != hipSuccess || per_cu < 1) { fprintf(stderr, "kernel_launch: occupancy query says %d\n", per_cu); }
        (void)hipGetLastError();
        grid = cus;
    }
    if (grid < 0) return;
    (void)hipMemsetAsync((char*)d_ws + WS_CTL, 0, CTL_ZERO_BYTES, stream);
    Args a{};
    for (int i = 0; i < 17; ++i) a.in[i] = (const float*)d_in[i];
    a.out = (float*)d_out; a.ws = (unsigned char*)d_ws;
#if MK_PER_PHASE
    for (int p = 0; p < N_PHASES; ++p) { a.ph_lo = p; a.ph_hi = p + 1; hipLaunchKernelGGL(fwd_kernel, dim3(grid), dim3(NTHREADS), LDS_BYTES, stream, a); }
#else
    a.ph_lo = 0; a.ph_hi = N_PHASES;
    hipLaunchKernelGGL(fwd_kernel, dim3(grid), dim3(NTHREADS), LDS_BYTES, stream, a);
#endif
}
```

```cpp
#include <hip/hip_runtime.h>
#include <cstdio>
#include <cstdint>

#ifndef REP_MASK
#define REP_MASK 0
#endif
#ifndef MK_PER_PHASE
#define MK_PER_PHASE 0
#endif

#define LAS __attribute__((address_space(3)))
#define GAS __attribute__((address_space(1)))
typedef unsigned short bf16_t;
typedef short bf16x8 __attribute__((ext_vector_type(8)));
typedef short s16x4 __attribute__((ext_vector_type(4)));
typedef float f32x4 __attribute__((ext_vector_type(4)));
typedef float f32x2 __attribute__((ext_vector_type(2)));
typedef unsigned u32x4 __attribute__((ext_vector_type(4)));
typedef unsigned u32x2 __attribute__((ext_vector_type(2)));
typedef int i32x4 __attribute__((ext_vector_type(4)));
typedef int i32x8 __attribute__((ext_vector_type(8)));

constexpr int T = 32768, D = 1024, SEQ = 4096;
constexpr int NE = 16, DE = 1536, NROWS = 69632;
constexpr int NH = 8, NCH = 64, NBH = 64;
constexpr float ALPHA = 1.41421356237f;
constexpr float LN_EPS = 1e-5f, HN_EPS = 1e-6f;
constexpr int NWAVES = 8, NTHREADS = 512;

constexpr size_t MiB = 1u << 20;
constexpr size_t WS_CTL = 0, CTL_ZERO_BYTES = 1 * MiB;
constexpr size_t WS_TOK_E = 1 * MiB;
constexpr size_t WS_TOK_SLOT = 1 * MiB + 256 * 1024;
constexpr size_t WS_TOK_GATE = 1 * MiB + 512 * 1024;
constexpr size_t WS_GB = 2 * MiB, WS_GIB = 3 * MiB, WS_GCM = 4 * MiB;
constexpr size_t WS_CHST = 5 * MiB;
constexpr size_t WS_DN = 5 * MiB + 512 * 1024;
constexpr size_t WS_NST = 6 * MiB + 512 * 1024;
constexpr size_t WS_WC1 = 8 * MiB, WS_WC2 = 14 * MiB, WS_WM1 = 16 * MiB, WS_WM2 = 22 * MiB;
constexpr size_t WS_W13 = 24 * MiB;
constexpr size_t WS_W2 = 216 * MiB;
constexpr size_t WS_CST = 120 * MiB;
constexpr size_t WS_X8 = 184 * MiB;
constexpr size_t WS_SLOT_TOK = 264 * MiB;
constexpr size_t WS_WM1F8 = 268 * MiB;
constexpr size_t WS_V8 = 440 * MiB;
constexpr size_t WS_O8 = 736 * MiB;
constexpr size_t WS_LNST = 271 * MiB;
constexpr size_t WS_WM1I8 = 272 * MiB;
constexpr size_t WS_WM2F8 = 270 * MiB;
constexpr size_t WS_XB = 312 * MiB;
constexpr size_t WS_BUFB = 376 * MiB;
constexpr size_t WS_BUFC = 512 * MiB;
constexpr size_t WS_HMIX = 704 * MiB;
constexpr size_t WS_END = 768 * MiB;
constexpr int CW_BAR = 4096;
constexpr int CW_CNT = 8192;

constexpr int RING_BYTES = 131072;
constexpr int MISC_OFF = 155648;
constexpr int TILE_E_OFF = MISC_OFF + 64;
constexpr int TINFO_OFF = MISC_OFF + 384;
constexpr int GTAB_OFF = MISC_OFF + 1024;
constexpr int LDS_BYTES = 163840;

__device__ __forceinline__ unsigned cvt_pk_bf16(float lo, float hi) { unsigned r; asm volatile("v_cvt_pk_bf16_f32 %0, %1, %2" : "=v"(r) : "v"(lo), "v"(hi)); return r; }
typedef __bf16 bf16x2_t __attribute__((ext_vector_type(2)));
__device__ __forceinline__ unsigned cvt_pk_bf16_c(float lo, float hi) { const f32x2 v = {lo, hi}; return __builtin_bit_cast(unsigned, __builtin_convertvector(v, bf16x2_t)); }
__device__ __forceinline__ float bf_lo(unsigned w) { return __uint_as_float(w << 16); }
__device__ __forceinline__ float bf_hi(unsigned w) { return __uint_as_float(w & 0xffff0000u); }
__device__ __forceinline__ float wave_sum(float v) {
    int x = (int)__float_as_uint(v);
#define WS_STEP(ctrl, rmask) x = (int)__float_as_uint(__uint_as_float((unsigned)x) + __uint_as_float((unsigned)__builtin_amdgcn_update_dpp(0, x, ctrl, rmask, 0xf, false)))
    WS_STEP(0x111, 0xf); WS_STEP(0x112, 0xf); WS_STEP(0x114, 0xf); WS_STEP(0x118, 0xf); WS_STEP(0x142, 0xa); WS_STEP(0x143, 0xc);
#undef WS_STEP
    return __uint_as_float((unsigned)__builtin_amdgcn_readlane(x, 63));
}
constexpr float SC_X = 16.0f, SC_H = 16.0f, SC_W = 256.0f, SC_INV = 1.0f / 4096.0f, SC_Y = 256.0f;
__device__ __forceinline__ unsigned pk4_fp8(float a, float b, float c, float d) { int w = 0; w = __builtin_amdgcn_cvt_pk_fp8_f32(a, b, w, false); w = __builtin_amdgcn_cvt_pk_fp8_f32(c, d, w, true); return (unsigned)w; }
__device__ __forceinline__ unsigned pk4_fp8_sat(float a, float b, float c, float d) { return pk4_fp8(a, b, c, d); }
constexpr float SI_X = 26.0f, SI_W = 900.0f, SI_WV = 1800.0f;
__device__ __forceinline__ unsigned pk4_i8(float a, float b, float c, float d, float s) {
    constexpr float M = 12582912.0f;
    const unsigned ua = __builtin_bit_cast(unsigned, __builtin_amdgcn_fmed3f(__builtin_fmaf(a, s, M), M - 127.0f, M + 127.0f)), ub = __builtin_bit_cast(unsigned, __builtin_amdgcn_fmed3f(__builtin_fmaf(b, s, M), M - 127.0f, M + 127.0f));
    const unsigned uc = __builtin_bit_cast(unsigned, __builtin_amdgcn_fmed3f(__builtin_fmaf(c, s, M), M - 127.0f, M + 127.0f)), ud = __builtin_bit_cast(unsigned, __builtin_amdgcn_fmed3f(__builtin_fmaf(d, s, M), M - 127.0f, M + 127.0f));
    return __builtin_amdgcn_perm(ub, ua, 0x0c0c0400u) | __builtin_amdgcn_perm(ud, uc, 0x04000c0cu);
}
constexpr float SV8 = 55.0f, SO8 = 26.0f;
__device__ __forceinline__ float ubf(unsigned w, int k) { return (float)((w >> (8 * k)) & 0xffu); }
__device__ __forceinline__ u32x4 u8x8_bf16(u32x2 b, float inv) { const float off = -128.0f * inv; u32x4 o;
    o.x = cvt_pk_bf16(__builtin_fmaf(ubf(b.x, 0), inv, off), __builtin_fmaf(ubf(b.x, 1), inv, off)); o.y = cvt_pk_bf16(__builtin_fmaf(ubf(b.x, 2), inv, off), __builtin_fmaf(ubf(b.x, 3), inv, off));
    o.z = cvt_pk_bf16(__builtin_fmaf(ubf(b.y, 0), inv, off), __builtin_fmaf(ubf(b.y, 1), inv, off)); o.w = cvt_pk_bf16(__builtin_fmaf(ubf(b.y, 2), inv, off), __builtin_fmaf(ubf(b.y, 3), inv, off)); return o; }
#define LDS_WAIT() asm volatile("s_waitcnt lgkmcnt(0)" ::: "memory")
#define VM_WAIT() asm volatile("s_waitcnt vmcnt(0)" ::: "memory")

#define XB_TMO      128
#define XB_XCNT(j)  (256  + 64 * (j))
#define XB_XSUB(j)  (1280 + 64 * (j))
#define XB_XGEN(j)  (2304 + 64 * (j))
#define XB_TOP      3328
#define XB_TOPGEN   3392
#define XCD_BAR_WORDS 3456
#define XB_SPIN_CAP (1u << 18)
__device__ __forceinline__ unsigned xb_ld(unsigned* p)              { return __hip_atomic_load(p, __ATOMIC_RELAXED, __HIP_MEMORY_SCOPE_AGENT); }
__device__ __forceinline__ unsigned xb_add(unsigned* p, unsigned v) { return __hip_atomic_fetch_add(p, v, __ATOMIC_RELAXED, __HIP_MEMORY_SCOPE_AGENT); }
__device__ __forceinline__ unsigned xb_xcc_id() { return (unsigned)__builtin_amdgcn_s_getreg((3 << 11) | 20) & 0xFu; }
#define XB_SPIN(cond, bar) do { unsigned _sp = 0; while (cond) { __builtin_amdgcn_s_sleep(1); \
    if ((++_sp & 255u) == 0u) { if (xb_ld(&(bar)[XB_TMO])) break; if (_sp > XB_SPIN_CAP) { atomicAdd(&(bar)[XB_TMO], 1u); break; } } } } while (0)
struct XcdBarrier { unsigned* bar; unsigned x; volatile LAS unsigned* st; };
__device__ __forceinline__ XcdBarrier xcd_barrier_post(unsigned* bar, volatile LAS unsigned* st) {
    XcdBarrier b; b.bar = bar; b.x = xb_xcc_id(); b.st = st;
    if (threadIdx.x == 0) (void)xb_add(&bar[XB_XCNT(b.x)], 1u);
    return b;
}
__device__ __forceinline__ void xcd_barrier_complete(unsigned* bar, unsigned x, unsigned& nloc, unsigned& nx) {
    const unsigned G = gridDim.x * gridDim.y * gridDim.z;
    unsigned sum, cnt, mine, sp = 0u;
    for (;;) {
        sum = 0u; cnt = 0u; mine = 0u;
#pragma unroll
        for (unsigned j = 0; j < 16; ++j) { const unsigned c = xb_ld(&bar[XB_XCNT(j)]); sum += c; cnt += (c > 0u) ? 1u : 0u; mine = (j == x) ? c : mine; }
        if (sum == G) break;
        __builtin_amdgcn_s_sleep(1);
        if ((++sp & 255u) == 0u) { if (xb_ld(&bar[XB_TMO])) break; if (sp > XB_SPIN_CAP) { atomicAdd(&bar[XB_TMO], 1u); break; } }
    }
    nloc = mine > 0u ? mine : 1u; nx = cnt > 0u ? cnt : 1u;
}
__device__ __forceinline__ void xcd_barrier(const XcdBarrier& b) {
    asm volatile("s_waitcnt vmcnt(0)" ::: "memory");
    __syncthreads();
    if (threadIdx.x == 0) {
        unsigned* bar = b.bar;
        __builtin_amdgcn_s_waitcnt(0);
        unsigned nloc = b.st[0], nx = b.st[1];
        if (nloc == 0u) { xcd_barrier_complete(bar, b.x, nloc, nx); b.st[0] = nloc; b.st[1] = nx; }
        const unsigned old = xb_add(&bar[XB_XSUB(b.x)], 1u);
        const unsigned gen = old / nloc;
        if (old + 1u == (gen + 1u) * nloc) {
            __builtin_amdgcn_fence(__ATOMIC_RELEASE, "agent");
            asm volatile("s_waitcnt vmcnt(0)" ::: "memory");
            asm volatile("buffer_inv sc1" ::: "memory");
            const unsigned og = xb_add(&bar[XB_TOP], 1u);
            const unsigned tg = og / nx;
            if (og + 1u == (tg + 1u) * nx) xb_add(&bar[XB_TOPGEN], 1u);
            else XB_SPIN(xb_ld(&bar[XB_TOPGEN]) == tg, bar);
            asm volatile("s_waitcnt vmcnt(0)" ::: "memory");
        } else {
            asm volatile("buffer_inv sc1" ::: "memory");
            const unsigned kgen = b.st[2];
            XB_SPIN(xb_ld(&bar[XB_TOPGEN]) == kgen, bar);
            asm volatile("s_waitcnt vmcnt(0)" ::: "memory");
        }
        b.st[2] = b.st[2] + 1u;
    }
    __syncthreads();
}

namespace pg8 {
constexpr int BM = 256, BK = 64, HALF = 128, HTB = HALF * BK * 2, STAGE_BYTES = 8 * HTB, NXCD = 8, WGM = 8;
__host__ __device__ __forceinline__ int lds_byte(int r, int c) { const int st = (r >> 4) * 2 + (c >> 5), rr = r & 15, cc = c & 31, ob = rr * 64 + cc * 2; return st * 1024 + (ob ^ (((ob >> 9) & 1) << 5)); }
__host__ __device__ __forceinline__ void stage_rc(int b, int& R, int& C) { const int st = b / 1024, sb = b % 1024, swz = sb ^ (((sb >> 9) & 1) << 5); R = (st >> 1) * 16 + swz / 64; C = (st & 1) * 32 + (swz % 64) / 2; }
__host__ __device__ __forceinline__ int perm32(int rho) { const int n = rho >> 4, i = rho & 15; return 8 * (i >> 2) + 4 * n + (i & 3); }

struct Unit { int pm, pn; };
struct Gemm { const bf16_t* A; const bf16_t* Bt; int K; int grouped; const LAS unsigned char* tile_e; size_t estride;
              const int* slot_tok; const LAS int* tinfo; LAS int* gtab; };

struct StaticOrder {
    int nM, nN, nwg, G, c;
    __device__ void init(int nM_, int nN_, int G_, int c_) { nM = nM_; nN = nN_; nwg = nM * nN; G = G_; c = c_; }
    __device__ bool next(int i, Unit& u) const {
        const long L = (long)i * G + c; if (L >= nwg) return false;
        int wgid = (int)L; { const int q = nwg / NXCD, r = nwg % NXCD, xcd = wgid % NXCD, off = wgid / NXCD; wgid = (xcd < r ? xcd * (q + 1) : r * (q + 1) + (xcd - r) * q) + off; }
        const int nig = WGM * nN, gid = wgid / nig, fm = gid * WGM, gsz = (nM - fm) < WGM ? (nM - fm) : WGM;
        u.pm = fm + ((wgid % nig) % gsz); u.pn = (wgid % nig) / gsz; return true;
    }
};

struct EpiBf16S {
    static constexpr bool PERM = true;
    bf16_t* O; int ldc; int nscale; float scale;
    __device__ __forceinline__ void operator()(const f32x4 (&acc)[2][2][4][2], const Unit& u, int wr, int wc, int fr, int fq) const {
        const int row0 = u.pm * BM + wr * 64 + fr, col0 = u.pn * BM + wc * 32 + 8 * fq;
        const float sc = (u.pn < nscale) ? scale : 1.0f;
#pragma unroll
        for (int ai = 0; ai < 2; ++ai)
#pragma unroll
            for (int m = 0; m < 4; ++m) { bf16_t* rowp = O + (size_t)(row0 + ai * HALF + m * 16) * ldc + col0;
#pragma unroll
                for (int bj = 0; bj < 2; ++bj) { const f32x4 v0 = acc[ai][bj][m][0] * sc, v1 = acc[ai][bj][m][1] * sc;
                    u32x4 w; w.x = cvt_pk_bf16(v0[0], v0[1]); w.y = cvt_pk_bf16(v0[2], v0[3]); w.z = cvt_pk_bf16(v1[0], v1[1]); w.w = cvt_pk_bf16(v1[2], v1[3]);
                    *(u32x4*)(rowp + bj * HALF) = w; } }
    }
};
struct EpiBf16SI8 {
    static constexpr bool PERM = true;
    bf16_t* O; int ldc; unsigned char* V8; unsigned char* O8;
    static constexpr float S0 = 1.0f / (SI_X * SI_W), SV = 1.0f / (SI_X * SI_WV), SQ = 0.125f * S0;
    __device__ __forceinline__ void operator()(const f32x4 (&acc)[2][2][4][2], const Unit& u, int wr, int wc, int fr, int fq) const {
        const int row0 = u.pm * BM + wr * 64 + fr;
        if (u.pn < 4) {
            const int col0 = u.pn * BM + wc * 32 + 8 * fq; const float s_ = (u.pn < 2) ? SQ : S0;
#pragma unroll
            for (int ai = 0; ai < 2; ++ai)
#pragma unroll
                for (int m = 0; m < 4; ++m) { bf16_t* rowp = O + (size_t)(row0 + ai * HALF + m * 16) * ldc + col0;
#pragma unroll
                    for (int bj = 0; bj < 2; ++bj) { const f32x4 v0 = __builtin_convertvector(__builtin_bit_cast(i32x4, acc[ai][bj][m][0]), f32x4) * s_, v1 = __builtin_convertvector(__builtin_bit_cast(i32x4, acc[ai][bj][m][1]), f32x4) * s_;
                        u32x4 w; w.x = cvt_pk_bf16(v0[0], v0[1]); w.y = cvt_pk_bf16(v0[2], v0[3]); w.z = cvt_pk_bf16(v1[0], v1[1]); w.w = cvt_pk_bf16(v1[2], v1[3]);
                        *(u32x4*)(rowp + bj * HALF) = w; } }
        } else {
            unsigned char* base = (u.pn < 8) ? V8 : O8; const float s8 = (u.pn < 8) ? SV * SV8 : S0 * SO8; const int cl = (u.pn & 3) * BM + wc * 32 + 8 * fq;
#pragma unroll
            for (int ai = 0; ai < 2; ++ai)
#pragma unroll
                for (int m = 0; m < 4; ++m) { unsigned char* rowp = base + (size_t)(row0 + ai * HALF + m * 16) * D + cl;
#pragma unroll
                    for (int bj = 0; bj < 2; ++bj) { const f32x4 v0 = __builtin_convertvector(__builtin_bit_cast(i32x4, acc[ai][bj][m][0]), f32x4), v1 = __builtin_convertvector(__builtin_bit_cast(i32x4, acc[ai][bj][m][1]), f32x4);
                        u32x2 w; w.x = pk4_i8(v0[0], v0[1], v0[2], v0[3], s8) ^ 0x80808080u; w.y = pk4_i8(v1[0], v1[1], v1[2], v1[3], s8) ^ 0x80808080u;
                        *(u32x2*)(rowp + bj * HALF) = w; } }
        }
    }
};
struct EpiResBf16 {
    static constexpr bool PERM = true;
    bf16_t* X; float alpha; float sc = 1.0f;
    __device__ __forceinline__ void operator()(const f32x4 (&acc)[2][2][4][2], const Unit& u, int wr, int wc, int fr, int fq) const {
        const int row0 = u.pm * BM + wr * 64 + fr, col0 = u.pn * BM + wc * 32 + 8 * fq;
        u32x4 r[2][4][2];
#pragma unroll
        for (int ai = 0; ai < 2; ++ai)
#pragma unroll
            for (int m = 0; m < 4; ++m)
#pragma unroll
                for (int bj = 0; bj < 2; ++bj) r[ai][m][bj] = *(const u32x4*)(X + (size_t)(row0 + ai * HALF + m * 16) * D + col0 + bj * HALF);
        asm volatile("" ::: "memory");
#pragma unroll
        for (int ai = 0; ai < 2; ++ai)
#pragma unroll
            for (int m = 0; m < 4; ++m) { bf16_t* rowp = X + (size_t)(row0 + ai * HALF + m * 16) * D + col0;
#pragma unroll
                for (int bj = 0; bj < 2; ++bj) { const f32x4 a0 = acc[ai][bj][m][0] * sc, a1 = acc[ai][bj][m][1] * sc; const u32x4 q = r[ai][m][bj]; u32x4 w;
                    w.x = cvt_pk_bf16(bf_lo(q.x) * alpha + a0[0], bf_hi(q.x) * alpha + a0[1]); w.y = cvt_pk_bf16(bf_lo(q.y) * alpha + a0[2], bf_hi(q.y) * alpha + a0[3]);
                    w.z = cvt_pk_bf16(bf_lo(q.z) * alpha + a1[0], bf_hi(q.z) * alpha + a1[1]); w.w = cvt_pk_bf16(bf_lo(q.w) * alpha + a1[2], bf_hi(q.w) * alpha + a1[3]);
                    *(u32x4*)(rowp + bj * HALF) = w; } }
    }
};
struct EpiMul {
    static constexpr bool PERM = true;
    bf16_t* O;
    __device__ __forceinline__ void operator()(const f32x4 (&acc)[2][2][4][2], const Unit& u, int wr, int wc, int fr, int fq) const {
        const int row0 = u.pm * BM + wr * 64 + fr, col0 = u.pn * HALF + wc * 32 + 8 * fq;
#pragma unroll
        for (int ai = 0; ai < 2; ++ai)
#pragma unroll
            for (int m = 0; m < 4; ++m) { bf16_t* rowp = O + (size_t)(row0 + ai * HALF + m * 16) * D + col0;
                const f32x4 p0 = acc[ai][0][m][0] * acc[ai][1][m][0], p1 = acc[ai][0][m][1] * acc[ai][1][m][1];
                u32x4 w; w.x = cvt_pk_bf16(p0[0], p0[1]); w.y = cvt_pk_bf16(p0[2], p0[3]); w.z = cvt_pk_bf16(p1[0], p1[1]); w.w = cvt_pk_bf16(p1[2], p1[3]);
                *(u32x4*)rowp = w; }
    }
};
struct EpiConvGate {
    static constexpr bool PERM = true;
    const bf16_t* U; const float* cw; bf16_t* Z;
    __device__ __forceinline__ void operator()(const f32x4 (&acc)[2][2][4][2], const Unit& u, int wr, int wc, int fr, int fq) const {
        const int row0 = u.pm * BM + wr * 64 + fr, col0 = u.pn * BM + wc * 32 + 8 * fq;
#pragma unroll
        for (int bj = 0; bj < 2; ++bj) { const int c = col0 + bj * HALF;
            f32x4 w0[2], w1[2], w2[2];
#pragma unroll
            for (int n = 0; n < 2; ++n) { const float* p = cw + c + 4 * n; w0[n] = *(const f32x4*)p; w1[n] = *(const f32x4*)(p + D); w2[n] = *(const f32x4*)(p + 2 * D); }
#pragma unroll
            for (int ai = 0; ai < 2; ++ai)
#pragma unroll
                for (int m = 0; m < 4; ++m) { const int r = row0 + ai * HALF + m * 16, t = r & (SEQ - 1);
                    const float m1 = t >= 1 ? 1.f : 0.f, m2 = t >= 2 ? 1.f : 0.f; const int r1 = r >= 1 ? r - 1 : 0, r2 = r >= 2 ? r - 2 : 0;
                    const u32x4 x0 = *(const u32x4*)(U + (size_t)r * D + c), x1 = *(const u32x4*)(U + (size_t)r1 * D + c), x2 = *(const u32x4*)(U + (size_t)r2 * D + c);
                    f32x4 z0, z1;
#pragma unroll
                    for (int q = 0; q < 2; ++q) {
                        z0[2 * q]     = acc[ai][bj][m][0][2 * q]     * (w2[0][2 * q]     * bf_lo(x0[q]) + m1 * w1[0][2 * q]     * bf_lo(x1[q]) + m2 * w0[0][2 * q]     * bf_lo(x2[q]));
                        z0[2 * q + 1] = acc[ai][bj][m][0][2 * q + 1] * (w2[0][2 * q + 1] * bf_hi(x0[q]) + m1 * w1[0][2 * q + 1] * bf_hi(x1[q]) + m2 * w0[0][2 * q + 1] * bf_hi(x2[q]));
                        z1[2 * q]     = acc[ai][bj][m][1][2 * q]     * (w2[1][2 * q]     * bf_lo(x0[2 + q]) + m1 * w1[1][2 * q]     * bf_lo(x1[2 + q]) + m2 * w0[1][2 * q]     * bf_lo(x2[2 + q]));
                        z1[2 * q + 1] = acc[ai][bj][m][1][2 * q + 1] * (w2[1][2 * q + 1] * bf_hi(x0[2 + q]) + m1 * w1[1][2 * q + 1] * bf_hi(x1[2 + q]) + m2 * w0[1][2 * q + 1] * bf_hi(x2[2 + q])); }
                    u32x4 w; w.x = cvt_pk_bf16(z0[0], z0[1]); w.y = cvt_pk_bf16(z0[2], z0[3]); w.z = cvt_pk_bf16(z1[0], z1[1]); w.w = cvt_pk_bf16(z1[2], z1[3]);
                    *(u32x4*)(Z + (size_t)r * D + c) = w;
                    if (m & 1) asm volatile("" ::: "memory"); }
        }
    }
};
struct EpiFp8S {
    static constexpr bool PERM = true;
    unsigned char* O; float scale;
    __device__ __forceinline__ void operator()(const f32x4 (&acc)[2][2][4][2], const Unit& u, int wr, int wc, int fr, int fq) const {
        const int row0 = u.pm * BM + wr * 64 + fr, col0 = u.pn * BM + wc * 32 + 8 * fq;
#pragma unroll
        for (int ai = 0; ai < 2; ++ai)
#pragma unroll
            for (int m = 0; m < 4; ++m) { unsigned char* rowp = O + (size_t)(row0 + ai * HALF + m * 16) * D + col0;
#pragma unroll
                for (int bj = 0; bj < 2; ++bj) { const f32x4 v0 = acc[ai][bj][m][0] * scale, v1 = acc[ai][bj][m][1] * scale;
                    u32x2 w; w.x = pk4_fp8_sat(v0[0], v0[1], v0[2], v0[3]); w.y = pk4_fp8_sat(v1[0], v1[1], v1[2], v1[3]);
                    *(u32x2*)(rowp + bj * HALF) = w; } }
    }
};
struct EpiSwiGLU8 {
    static constexpr bool PERM = true;
    unsigned char* O;
    __device__ __forceinline__ void operator()(const f32x4 (&acc)[2][2][4][2], const Unit& u, int wr, int wc, int fr, int fq) const {
        const int row0 = u.pm * BM + wr * 64 + fr, col0 = u.pn * HALF + wc * 32 + 8 * fq;
#pragma unroll
        for (int ai = 0; ai < 2; ++ai)
#pragma unroll
            for (int m = 0; m < 4; ++m) { unsigned char* rowp = O + (size_t)(row0 + ai * HALF + m * 16) * DE + col0;
                float h[8];
#pragma unroll
                for (int n = 0; n < 2; ++n)
#pragma unroll
                    for (int jp = 0; jp < 2; ++jp) { const f32x2 a = {acc[ai][0][m][n][2 * jp], acc[ai][0][m][n][2 * jp + 1]}, b = {acc[ai][1][m][n][2 * jp], acc[ai][1][m][n][2 * jp + 1]};
                        constexpr float KD = 1.0f / (SC_INV * SC_INV * SC_H); const f32x2 kd = {KD, KD};
                        const f32x2 e = a * (-1.44269504089f * SC_INV); const f32x2 t = {__builtin_amdgcn_exp2f(e[0]), __builtin_amdgcn_exp2f(e[1])};
                        const f32x2 d = __builtin_elementwise_fma(t, kd, kd); const f32x2 r = {__builtin_amdgcn_rcpf(d[0]), __builtin_amdgcn_rcpf(d[1])};
                        const f32x2 hh = (a * b) * r; h[n * 4 + 2 * jp] = hh[0]; h[n * 4 + 2 * jp + 1] = hh[1]; }
                u32x2 w; w.x = pk4_fp8_sat(h[0], h[1], h[2], h[3]); w.y = pk4_fp8_sat(h[4], h[5], h[6], h[7]);
                *(u32x2*)rowp = w; }
    }
};

template <class Epi, bool FP8 = false, bool ALIGN_EPI = true, bool GATHER = false, bool I8 = false>
__device__ __forceinline__ void gemm_phase(LAS unsigned char* lds, const Gemm g, const StaticOrder& S, const Epi& E) {
    const int tid = threadIdx.x, wid = __builtin_amdgcn_readfirstlane(tid >> 6), lane = tid & 63, wr = wid >> 2, wc = wid & 3, fr = lane & 15, fq = lane >> 4;
    const int K = g.K, nt = K / BK;
    unsigned voffA[2], voffB[2]; int rowA[2];
#pragma unroll
    for (int i = 0; i < 2; ++i) { int R, C; stage_rc(tid * 16 + i * 8192, R, C); const int Rb = Epi::PERM ? ((R & ~31) + perm32(R & 31)) : R;
        voffA[i] = GATHER ? (unsigned)C * 2u : (unsigned)(R * K + C) * 2u; voffB[i] = (unsigned)(Rb * K + C) * 2u; rowA[i] = R; }
    const size_t kstep = (size_t)(BK * 2);
    const size_t hstep = (size_t)HALF * K * 2;
    const size_t tstep = 2 * hstep;
    const unsigned ldsw = (unsigned)wid * 1024u;
    const int aoff = lds_byte(wr * 64 + fr, fq * 8), boff = lds_byte(wc * 32 + fr, fq * 8);
#define PG8_SA(b, h) (((b) * 2 + (h)) * HTB)
#define PG8_SB(b, h) ((4 + (b) * 2 + (h)) * HTB)
#define PG8_STAGE(bufoff, gbase, voff) do { _Pragma("unroll") for (int _i = 0; _i < 2; ++_i) \
        __builtin_amdgcn_global_load_lds((const unsigned*)((const char*)(gbase) + (voff)[_i]), (LAS unsigned*)(lds + (bufoff) + ldsw + _i * 8192), 16, 0, 0); } while (0)
#define PG8_LD8(base) __builtin_shufflevector(*(const LAS i32x4*)(lds + (base)), *(const LAS i32x4*)(lds + (base) + 1024), 0, 1, 2, 3, 4, 5, 6, 7)
#define PG8_LDA(dst, b, h) do { _Pragma("unroll") for (int m = 0; m < 4; ++m) dst[m] = PG8_LD8(PG8_SA(b, h) + aoff + m * 2048); } while (0)
#define PG8_LDB(dst, b, h) do { _Pragma("unroll") for (int n = 0; n < 2; ++n) dst[n] = PG8_LD8(PG8_SB(b, h) + boff + n * 2048); } while (0)
#define PG8_LO4(x) __builtin_bit_cast(bf16x8, __builtin_shufflevector((x), (x), 0, 1, 2, 3))
#define PG8_HI4(x) __builtin_bit_cast(bf16x8, __builtin_shufflevector((x), (x), 4, 5, 6, 7))
#define PG8_MMA(ai, bj, At, Bt) do { __builtin_amdgcn_s_setprio(1); \
        if constexpr (FP8) { _Pragma("unroll") for (int m = 0; m < 4; ++m) _Pragma("unroll") for (int n = 0; n < 2; ++n) \
            asm volatile("v_mfma_f32_16x16x128_f8f6f4 %0, %1, %2, %0" : "+v"(acc[ai][bj][m][n]) : "v"(Bt[n]), "v"(At[m])); } \
        else if constexpr (I8) {   \
            _Pragma("unroll") for (int m = 0; m < 4; ++m) _Pragma("unroll") for (int n = 0; n < 2; ++n) \
                asm volatile("v_mfma_i32_16x16x64_i8 %0, %1, %2, %0" : "+v"(acc[ai][bj][m][n]) : "v"(__builtin_shufflevector(Bt[n], Bt[n], 0, 1, 2, 3)), "v"(__builtin_shufflevector(At[m], At[m], 0, 1, 2, 3))); \
            _Pragma("unroll") for (int m = 0; m < 4; ++m) _Pragma("unroll") for (int n = 0; n < 2; ++n) \
                asm volatile("v_mfma_i32_16x16x64_i8 %0, %1, %2, %0" : "+v"(acc[ai][bj][m][n]) : "v"(__builtin_shufflevector(Bt[n], Bt[n], 4, 5, 6, 7)), "v"(__builtin_shufflevector(At[m], At[m], 4, 5, 6, 7))); } \
        else { _Pragma("unroll") for (int m = 0; m < 4; ++m) _Pragma("unroll") for (int n = 0; n < 2; ++n) { \
            acc[ai][bj][m][n] = __builtin_amdgcn_mfma_f32_16x16x32_bf16(PG8_LO4(Bt[n]), PG8_LO4(At[m]), acc[ai][bj][m][n], 0, 0, 0); \
            acc[ai][bj][m][n] = __builtin_amdgcn_mfma_f32_16x16x32_bf16(PG8_HI4(Bt[n]), PG8_HI4(At[m]), acc[ai][bj][m][n], 0, 0, 0); } } \
        __builtin_amdgcn_s_setprio(0); } while (0)
#define PG8_MMA_Z(ai, bj, At, Bt) do { __builtin_amdgcn_s_setprio(1); \
        if constexpr (FP8) { _Pragma("unroll") for (int m = 0; m < 4; ++m) _Pragma("unroll") for (int n = 0; n < 2; ++n) \
            asm volatile("v_mfma_f32_16x16x128_f8f6f4 %0, %1, %2, 0" : "=v"(acc[ai][bj][m][n]) : "v"(Bt[n]), "v"(At[m])); } \
        else if constexpr (I8) { \
            _Pragma("unroll") for (int m = 0; m < 4; ++m) _Pragma("unroll") for (int n = 0; n < 2; ++n) \
                asm volatile("v_mfma_i32_16x16x64_i8 %0, %1, %2, 0" : "=v"(acc[ai][bj][m][n]) : "v"(__builtin_shufflevector(Bt[n], Bt[n], 0, 1, 2, 3)), "v"(__builtin_shufflevector(At[m], At[m], 0, 1, 2, 3))); \
            _Pragma("unroll") for (int m = 0; m < 4; ++m) _Pragma("unroll") for (int n = 0; n < 2; ++n) \
                asm volatile("v_mfma_i32_16x16x64_i8 %0, %1, %2, %0" : "+v"(acc[ai][bj][m][n]) : "v"(__builtin_shufflevector(Bt[n], Bt[n], 4, 5, 6, 7)), "v"(__builtin_shufflevector(At[m], At[m], 4, 5, 6, 7))); } \
        else { _Pragma("unroll") for (int m = 0; m < 4; ++m) _Pragma("unroll") for (int n = 0; n < 2; ++n) { \
            acc[ai][bj][m][n] = __builtin_amdgcn_mfma_f32_16x16x32_bf16(PG8_LO4(Bt[n]), PG8_LO4(At[m]), (f32x4){0.f, 0.f, 0.f, 0.f}, 0, 0, 0); \
            acc[ai][bj][m][n] = __builtin_amdgcn_mfma_f32_16x16x32_bf16(PG8_HI4(Bt[n]), PG8_HI4(At[m]), acc[ai][bj][m][n], 0, 0, 0); } } \
        __builtin_amdgcn_s_setprio(0); } while (0)
#define PG8_WAIT_V(n) asm volatile("s_waitcnt vmcnt(" #n ")" ::: "memory")
#define PG8_WAIT_L(n) asm volatile("s_waitcnt lgkmcnt(" #n ")" ::: "memory")
#define PG8_BAR __builtin_amdgcn_s_barrier()
#define PG8_SCHED __builtin_amdgcn_sched_barrier(0)
#define PG8_BPTR(u) ((const char*)g.Bt + ((g.grouped ? (size_t)g.tile_e[(u).pm] * g.estride * 2 : (size_t)0) + (size_t)(u).pn * tstep))
#define PG8_GT_ISSUE(u, buf) do { if (wid < 4) { const int e_ = g.tile_e[(u).pm]; const int lrb_ = ((u).pm - g.tinfo[e_]) * 256; \
        __builtin_amdgcn_global_load_lds((const unsigned*)(g.slot_tok + (size_t)e_ * 32768 + lrb_ + wid * 64 + lane), (LAS unsigned*)(g.gtab + (buf) * 256 + wid * 64), 4, 0, 0); } } while (0)
#define PG8_GT_READ(u, buf, off) do { const int e_ = g.tile_e[(u).pm]; const int lrb_ = ((u).pm - g.tinfo[e_]) * 256, cnt_ = g.tinfo[16 + e_]; \
        _Pragma("unroll") for (int h_ = 0; h_ < 2; ++h_) _Pragma("unroll") for (int i_ = 0; i_ < 2; ++i_) { const int lr_ = h_ * HALF + rowA[i_]; const int v_ = g.gtab[(buf) * 256 + lr_]; \
            off[h_][i_] = (unsigned)((lrb_ + lr_ < cnt_) ? v_ : 0) * (unsigned)(2 * K) + voffA[i_]; } } while (0)
    Unit cur, nxt; int ui = 0;
    if (!S.next(0, cur)) return;
    unsigned goff[2][2], noff[2][2];
    if constexpr (GATHER) { PG8_GT_ISSUE(cur, 0); PG8_WAIT_V(0); PG8_BAR; PG8_GT_READ(cur, 0, goff);
#pragma unroll
        for (int h_ = 0; h_ < 2; ++h_)
#pragma unroll
            for (int i_ = 0; i_ < 2; ++i_) noff[h_][i_] = goff[h_][i_]; }
    f32x4 acc[2][2][4][2];
    i32x8 At[4], B0[2], B1[2];
    const char* cA = GATHER ? (const char*)g.A : (const char*)g.A + (size_t)cur.pm * tstep; const char* cB = PG8_BPTR(cur);
#define PG8_STAGE_A(bufoff, gbase, h, offs) do { if constexpr (GATHER) PG8_STAGE(bufoff, gbase, (offs)[h]); else PG8_STAGE(bufoff, (gbase) + (h) * hstep, voffA); } while (0)
    PG8_STAGE(PG8_SB(0, 0), cB, voffB); PG8_STAGE(PG8_SB(0, 1), cB + hstep, voffB); PG8_STAGE_A(PG8_SA(0, 0), cA, 0, goff); PG8_STAGE_A(PG8_SA(0, 1), cA, 1, goff);
    if (wr == 1) PG8_BAR;
    PG8_WAIT_V(2); PG8_BAR;
    PG8_STAGE(PG8_SB(1, 0), cB + kstep, voffB); PG8_STAGE_A(PG8_SA(1, 0), cA + kstep, 0, goff); PG8_STAGE(PG8_SB(1, 1), cB + hstep + kstep, voffB);
    PG8_WAIT_V(6); PG8_BAR;
    for (;;) {
        const bool has_next = S.next(ui + 1, nxt);
        const char* nA = GATHER ? cA : (has_next ? (const char*)g.A + (size_t)nxt.pm * tstep : cA); const char* nB = has_next ? PG8_BPTR(nxt) : cB;
        if constexpr (GATHER) { if (has_next) PG8_GT_ISSUE(nxt, (ui + 1) & 1); }
#define PG8_KSTEP(t, last, MM1) do { \
            unsigned o2[2][2]; \
            if constexpr (GATHER) { \
                if (last && has_next) PG8_GT_READ(nxt, (ui + 1) & 1, noff); \
_Pragma("unroll") \
                for (int h_ = 0; h_ < 2; ++h_) \
_Pragma("unroll") \
                    for (int i_ = 0; i_ < 2; ++i_) o2[h_][i_] = last ? noff[h_][i_] : goff[h_][i_]; } \
            const char* a1 = cA + (size_t)(t + 1) * kstep; \
            const char* a2 = last ? nA : cA + (size_t)(t + 2) * kstep; const char* b2 = last ? nB : cB + (size_t)(t + 2) * kstep; \
            const char* a3 = a2 + kstep; const char* b3 = b2 + kstep; \
            PG8_LDB(B0, 0, 0); PG8_LDB(B1, 0, 1); PG8_SCHED; PG8_LDA(At, 0, 0); PG8_STAGE_A(PG8_SA(1, 1), a1, 1, goff); \
            PG8_WAIT_V(8); PG8_WAIT_L(0); PG8_BAR; MM1(0, 0, At, B0); MM1(0, 1, At, B1); PG8_BAR; PG8_SCHED; \
            PG8_LDA(At, 0, 1); PG8_STAGE(PG8_SB(0, 0), b2, voffB); PG8_STAGE(PG8_SB(0, 1), b2 + hstep, voffB); PG8_STAGE_A(PG8_SA(0, 0), a2, 0, o2); \
            PG8_WAIT_V(8); PG8_WAIT_L(0); PG8_BAR; MM1(1, 0, At, B0); MM1(1, 1, At, B1); PG8_BAR; PG8_SCHED; \
            PG8_LDB(B0, 1, 0); PG8_LDB(B1, 1, 1); PG8_SCHED; PG8_LDA(At, 1, 0); PG8_STAGE_A(PG8_SA(0, 1), a2, 1, o2); \
            PG8_WAIT_V(8); PG8_WAIT_L(0); PG8_BAR; PG8_MMA(0, 0, At, B0); PG8_MMA(0, 1, At, B1); PG8_BAR; PG8_SCHED; \
            PG8_LDA(At, 1, 1); PG8_STAGE(PG8_SB(1, 0), b3, voffB); PG8_STAGE(PG8_SB(1, 1), b3 + hstep, voffB); PG8_STAGE_A(PG8_SA(1, 0), a3, 0, o2); \
            PG8_WAIT_V(8); PG8_WAIT_L(0); PG8_BAR; PG8_MMA(1, 0, At, B0); PG8_MMA(1, 1, At, B1); PG8_BAR; PG8_SCHED; \
        } while (0)
        if constexpr (FP8 || I8) {
            PG8_KSTEP(0, false, PG8_MMA_Z);
            for (int t = 2; t < nt; t += 2) { const bool last = (t == nt - 2); PG8_KSTEP(t, last, PG8_MMA); }
        } else {
#pragma unroll
            for (int a = 0; a < 2; ++a)
#pragma unroll
                for (int b = 0; b < 2; ++b)
#pragma unroll
                    for (int m = 0; m < 4; ++m)
#pragma unroll
                        for (int n = 0; n < 2; ++n) acc[a][b][m][n] = (f32x4){0.f, 0.f, 0.f, 0.f};
            for (int t = 0; t < nt; t += 2) { const bool last = (t == nt - 2); PG8_KSTEP(t, last, PG8_MMA); }
        }
        if constexpr (FP8 || I8) asm volatile("s_nop 15\n\ts_nop 15" ::: "memory");
        if constexpr (FP8) { if (has_next) {
            int l_; asm volatile("v_mbcnt_lo_u32_b32 %0, -1, 0\n\tv_mbcnt_hi_u32_b32 %0, -1, %0" : "=v"(l_)); const int kt_ = 2 * (nxt.pm & 7) + (wid >> 2), r_ = (wid & 3) * 64 + l_;
            if (kt_ < nt) __builtin_amdgcn_global_load_lds((const unsigned*)(nB + (size_t)r_ * (size_t)(K * 2) + (size_t)kt_ * kstep), (LAS unsigned*)(lds + 131072 + wid * 256), 4, 0, 0); } }
        if constexpr (ALIGN_EPI) { if (wr == 0) PG8_BAR; }
        E(acc, cur, wr, wc, fr, fq);
        if (!has_next) break;
        cur = nxt; cA = nA; cB = nB; ++ui;
        if constexpr (GATHER) {
#pragma unroll
            for (int h_ = 0; h_ < 2; ++h_)
#pragma unroll
                for (int i_ = 0; i_ < 2; ++i_) goff[h_][i_] = noff[h_][i_]; }
        if constexpr (ALIGN_EPI) { if (wr == 1) PG8_BAR; }
    }
    PG8_WAIT_V(0);
    if constexpr (!ALIGN_EPI) { if (wr == 0) PG8_BAR; }
    PG8_BAR;
#undef PG8_SA
#undef PG8_SB
#undef PG8_STAGE
#undef PG8_LDA
#undef PG8_LDB
#undef PG8_MMA
#undef PG8_MMA_Z
#undef PG8_KSTEP
#undef PG8_LO4
#undef PG8_HI4
#undef PG8_LD8
#undef PG8_WAIT_V
#undef PG8_WAIT_L
#undef PG8_BAR
#undef PG8_SCHED
#undef PG8_BPTR
#undef PG8_STAGE_A
#undef PG8_GT_ISSUE
#undef PG8_GT_READ
}
}

struct Args { const float* in[17]; float* out; unsigned char* ws; int ph_lo, ph_hi; };

struct Ctx {
    LAS unsigned char* lds;
    unsigned char* ws; unsigned* ctl;
    int tid, lane, wave, G, bid;
};

__device__ __forceinline__ void transpose_item(const float* W, int ldn, int K, bf16_t* WT, int k0, int n0, int drow0, LAS float* scr, int lane) {
#pragma unroll 8
    for (int i = 0; i < 32; ++i) { const int kk = 2 * i + (lane >> 5); scr[kk * 33 + (lane & 31)] = W[(size_t)(k0 + kk) * ldn + n0 + (lane & 31)]; }
    LDS_WAIT(); asm volatile("" ::: "memory");
    const int c = lane & 7;
#pragma unroll
    for (int j = 0; j < 4; ++j) { const int n = (lane >> 3) + 8 * j; const LAS float* s = scr + (8 * c) * 33 + n;
        u32x4 o; o.x = cvt_pk_bf16(s[0 * 33], s[1 * 33]); o.y = cvt_pk_bf16(s[2 * 33], s[3 * 33]); o.z = cvt_pk_bf16(s[4 * 33], s[5 * 33]); o.w = cvt_pk_bf16(s[6 * 33], s[7 * 33]);
        *(u32x4*)(WT + (size_t)(drow0 + n) * K + k0 + 8 * c) = o; }
    LDS_WAIT(); asm volatile("" ::: "memory");
}
struct XItem { const float* src; unsigned char* dst; int ldn, K; };
__device__ __forceinline__ XItem expert_item(const Ctx& F, const Args& a, int r, int lane) {
    const int le = r / 576, rr = r - le * 576, kind = rr / 192, q = rr - kind * 192;
    const int nq = lane & 15, kr = lane >> 4; XItem x;
    if (kind < 2) { const int kb = q / 24, nb = q - kb * 24, n0 = 64 * nb, k0 = 128 * kb; x.ldn = 1536; x.K = 1024;
        x.src = (kind == 0 ? a.in[14] : a.in[15]) + (size_t)le * 1024 * 1536 + (size_t)(k0 + 32 * kr) * 1536 + n0 + 4 * nq;
        x.dst = (unsigned char*)(F.ws + WS_W13) + (size_t)le * 3072 * 1024 + (size_t)(256 * (n0 >> 7) + (n0 & 127) + 128 * kind + 4 * nq) * 1024 + k0 + 32 * kr; }
    else { const int kb = q / 16, nb = q - kb * 16, n0 = 64 * nb, k0 = 128 * kb; x.ldn = 1024; x.K = 1536;
        x.src = a.in[16] + (size_t)le * 1536 * 1024 + (size_t)(k0 + 32 * kr) * 1024 + n0 + 4 * nq;
        x.dst = (unsigned char*)(F.ws + WS_W2) + (size_t)le * 1024 * 1536 + (size_t)(n0 + 4 * nq) * 1536 + k0 + 32 * kr; }
    return x;
}
__device__ __forceinline__ void xitem_run(const XItem& x) {
    f32x4 v[32];
#pragma unroll
    for (int i = 0; i < 32; ++i) v[i] = *(const f32x4*)(x.src + (size_t)i * x.ldn);
#pragma unroll
    for (int j = 0; j < 4; ++j)
#pragma unroll
        for (int hh = 0; hh < 2; ++hh) { u32x4 o;
#pragma unroll
            for (int q = 0; q < 4; ++q) o[q] = pk4_fp8(v[16 * hh + 4 * q][j] * SC_W, v[16 * hh + 4 * q + 1][j] * SC_W, v[16 * hh + 4 * q + 2][j] * SC_W, v[16 * hh + 4 * q + 3][j] * SC_W);
            *(u32x4*)(x.dst + (size_t)j * x.K + 16 * hh) = o; }
}
__device__ __forceinline__ void xitem_run_i8(const XItem& x, float sc) {
    f32x4 v[32];
#pragma unroll
    for (int i = 0; i < 32; ++i) v[i] = *(const f32x4*)(x.src + (size_t)i * x.ldn);
#pragma unroll
    for (int j = 0; j < 4; ++j)
#pragma unroll
        for (int hh = 0; hh < 2; ++hh) { u32x4 o;
#pragma unroll
            for (int q = 0; q < 4; ++q) o[q] = pk4_i8(v[16 * hh + 4 * q][j], v[16 * hh + 4 * q + 1][j], v[16 * hh + 4 * q + 2][j], v[16 * hh + 4 * q + 3][j], sc);
            *(u32x4*)(x.dst + (size_t)j * x.K + 16 * hh) = o; }
}
__device__ __forceinline__ void p0_prologue(const Ctx& F, const Args& a) {
    LAS float* scr = (LAS float*)(F.lds + F.wave * 16384);
    const int gw = F.bid * NWAVES + F.wave, NGW = F.G * NWAVES;
    constexpr int I_A = 16 * 96, I_B = 16 * 32;
    constexpr int I_DENSE = I_A + I_B;
    for (int it = gw; it < I_DENSE; it += NGW) {
        int r = it;
        if (r < I_A) { const int n0 = 32 * (r % 96), ch = n0 & 1023;
            transpose_item(a.in[1], 3072, 1024, (bf16_t*)(F.ws + WS_WC1), 64 * (r / 96), n0, n0 < 1024 ? 2048 + n0 : 256 * (ch >> 7) + (ch & 127) + (n0 >= 2048 ? 128 : 0), scr, F.lane); continue; } r -= I_A;
        { transpose_item(a.in[3], 1024, 1024, (bf16_t*)(F.ws + WS_WC2), 64 * (r / 32), 32 * (r % 32), 32 * (r % 32), scr, F.lane); }
    }
    const float* x = a.in[0]; bf16_t* xb = (bf16_t*)(F.ws + WS_XB);
    for (int m = gw; m < T; m += NGW) {
        const f32x4* xr = (const f32x4*)(x + (size_t)m * D) + F.lane; u32x2* o = (u32x2*)(xb + (size_t)m * D) + F.lane;
#pragma unroll
        for (int j = 0; j < 4; ++j) { const f32x4 v = xr[64 * j]; u32x2 w; w.x = cvt_pk_bf16(v[0], v[1]); w.y = cvt_pk_bf16(v[2], v[3]); o[64 * j] = w; }
    }
    constexpr int NX = 32 * 576;
    for (int it = gw; it < NX; it += NGW) { const XItem xi = expert_item(F, a, it, F.lane); xitem_run(xi); }
    for (int it = gw; it < 128; it += NGW) { const int kb = it >> 4, nb = it & 15, nq = F.lane & 15, kr = F.lane >> 4; XItem xi; xi.ldn = 1024; xi.K = 1024;
        xi.src = a.in[7] + (size_t)(128 * kb + 32 * kr) * 1024 + 64 * nb + 4 * nq; xi.dst = (unsigned char*)(F.ws + WS_WM2F8) + (size_t)(64 * nb + 4 * nq) * 1024 + 128 * kb + 32 * kr; xitem_run(xi); }
    for (int it = gw; it < 384; it += NGW) { const int kb = it / 48, nb = it - kb * 48, nq = F.lane & 15, kr = F.lane >> 4; XItem xi; xi.ldn = 3088; xi.K = 1024;
        xi.src = a.in[4] + (size_t)(128 * kb + 32 * kr) * 3088 + 64 * nb + 4 * nq; xi.dst = (unsigned char*)(F.ws + WS_WM1I8) + (size_t)(64 * nb + 4 * nq) * 1024 + 128 * kb + 32 * kr;
        xitem_run_i8(xi, (nb >= 16 && nb < 32) ? SI_WV : SI_W); }
}

__device__ __forceinline__ float reduce16(const float (&a)[16], int lane) {
    const bool h5 = (lane & 32) != 0, h4 = (lane & 16) != 0, h3 = (lane & 8) != 0, h2 = (lane & 4) != 0;
    float b[8], c[4], d[2];
#pragma unroll
    for (int i = 0; i < 8; ++i) { const float send = h5 ? a[i] : a[i + 8]; const float keep = h5 ? a[i + 8] : a[i]; b[i] = keep + __shfl_xor(send, 32); }
#pragma unroll
    for (int i = 0; i < 4; ++i) { const float send = h4 ? b[i] : b[i + 4]; const float keep = h4 ? b[i + 4] : b[i]; c[i] = keep + __shfl_xor(send, 16); }
#pragma unroll
    for (int i = 0; i < 2; ++i) { const float send = h3 ? c[i] : c[i + 2]; const float keep = h3 ? c[i + 2] : c[i]; d[i] = keep + __shfl_xor(send, 8); }
    const float send = h2 ? d[0] : d[1]; const float keep = h2 ? d[1] : d[0]; float e = keep + __shfl_xor(send, 4);
    e += __shfl_xor(e, 2); e += __shfl_xor(e, 1);
    return e;
}
__device__ __forceinline__ void reduce16b(const float (&a)[16], float (&t)[4]) {
    float b[8], c[4];
#pragma unroll
    for (int i = 0; i < 8; ++i) { const auto r = __builtin_amdgcn_permlane32_swap(__float_as_uint(a[i]), __float_as_uint(a[i + 8]), false, false); b[i] = __uint_as_float(r[0]) + __uint_as_float(r[1]); }
#pragma unroll
    for (int i = 0; i < 4; ++i) { const auto r = __builtin_amdgcn_permlane16_swap(__float_as_uint(b[i]), __float_as_uint(b[i + 4]), false, false); c[i] = __uint_as_float(r[0]) + __uint_as_float(r[1]); }
#pragma unroll
    for (int i = 0; i < 4; ++i) { int x = (int)__float_as_uint(c[i]);
#define R16_STEP(ctrl) x = (int)__float_as_uint(__uint_as_float((unsigned)x) + __uint_as_float((unsigned)__builtin_amdgcn_update_dpp(0, x, ctrl, 0xf, 0xf, false)))
        R16_STEP(0x111); R16_STEP(0x112); R16_STEP(0x114); R16_STEP(0x118);
#undef R16_STEP
        t[i] = __uint_as_float((unsigned)x); }
}
__device__ __forceinline__ float rdlane(float v, int l) { return __uint_as_float((unsigned)__builtin_amdgcn_readlane((int)__float_as_uint(v), l)); }

__device__ __forceinline__ int expert_pstart(const Ctx& F, int layer, int& ntiles_total, int& my_tiles) {
    const unsigned* gcnt = F.ctl + CW_CNT + layer * 16 * 64;
    int c = (F.lane < 16) ? (int)__hip_atomic_load(gcnt + F.lane * 64, __ATOMIC_RELAXED, __HIP_MEMORY_SCOPE_AGENT) : 0;
    const int tiles = (c + 255) >> 8; int incl = tiles;
#pragma unroll
    for (int o = 1; o < 16; o <<= 1) { const int tt = __shfl_up(incl, o); if (F.lane >= o) incl += tt; }
    ntiles_total = __builtin_amdgcn_readlane(incl, 15); my_tiles = tiles;
    return (incl - tiles) * 256;
}
constexpr int LN_WXS = 1028;
constexpr int LN_WX = 0, LN_ROWI = 66048  , LN_ROWG = 66048 + 2048  , LN_CNT = 66048 + 3072  , LN_GATES = 66048 + 4096  , LN_GM = 81920  , LN_BM = 86016  ;
__device__ __forceinline__ int ld_i32(const int* p) { return (int)__hip_atomic_load((const unsigned*)p, __ATOMIC_RELAXED, __HIP_MEMORY_SCOPE_AGENT); }
__device__ __forceinline__ float ld_f32(const float* p) { return __uint_as_float(__hip_atomic_load((const unsigned*)p, __ATOMIC_RELAXED, __HIP_MEMORY_SCOPE_AGENT)); }
template <int MODE>
__device__ __forceinline__ void ln_phase(const Ctx& F, const Args& a, int layer) {
    bf16_t* xs = (bf16_t*)(F.ws + WS_XB);
    unsigned char* x8 = (unsigned char*)(F.ws + WS_X8);
    const float* gvec = (MODE == 0 ? a.in[8] : a.in[10]) + layer * D; const float* bvec = (MODE == 0 ? a.in[9] : a.in[11]) + layer * D;
    LAS float* Wx = (LAS float*)(F.lds + LN_WX);
    LAS int* rowi = (LAS int*)(F.lds + LN_ROWI); LAS float* rowg = (LAS float*)(F.lds + LN_ROWG); LAS int* cnt = (LAS int*)(F.lds + LN_CNT);
    LAS float* gates = (LAS float*)(F.lds + LN_GATES);
    const int lane = F.lane;
    f32x4 gv[4], bv[4];
#pragma unroll
    for (int j = 0; j < 4; ++j) { gv[j] = *((const f32x4*)gvec + lane + 64 * j); bv[j] = *((const f32x4*)bvec + lane + 64 * j); }
    if (MODE == 0) {
#pragma unroll
        for (int j = 0; j < 4; ++j) { gv[j] = gv[j] * SC_X; bv[j] = bv[j] * SC_X; } }
    if (MODE != 2) {
        const float* W = (MODE == 0) ? a.in[12] : (a.in[4] + 3072); const int ldw = (MODE == 0) ? 16 : 3088;
        for (int i = F.tid; i < 16384; i += NTHREADS) { const int col = i >> 4, e = i & 15; Wx[e * LN_WXS + col] = W[(size_t)col * ldw + e] * (MODE == 0 ? 1.0f / SC_X : 1.0f); }
    }
    float* lnst = (float*)(F.ws + WS_LNST);
    LAS float* gmx = (LAS float*)(F.lds + LN_GM); LAS float* bmx = (LAS float*)(F.lds + LN_BM);
    if (MODE != 0) { for (int i = F.tid; i < D; i += NTHREADS) { gmx[i] = a.in[8][layer * D + i]; bmx[i] = ALPHA * a.in[9][layer * D + i]; } }
    const int* tok_e = (const int*)(F.ws + WS_TOK_E); const int* tok_slot = (const int*)(F.ws + WS_TOK_SLOT); const float* tok_gate = (const float*)(F.ws + WS_TOK_GATE);
    int pst = 0; if (MODE != 0) { int nt_, mt_; pst = expert_pstart(F, layer, nt_, mt_); }
    const unsigned char* yb = (const unsigned char*)(F.ws + WS_BUFB);
    for (int rblk = F.bid; rblk < T / 128; rblk += F.G) {
        if (MODE == 0 && F.tid < 32) cnt[F.tid] = 0;
        __syncthreads();
        const int R0 = rblk * 128, W0 = R0 + F.wave * 16;
        int dd0 = 0, dd1 = 0; float gg0 = 0.f, gg1 = 0.f, sm_ = 0.f, sr_ = 0.f;
        if (MODE != 0) { const int rowl = W0 + (lane & 15); const int ee = ld_i32(tok_e + rowl);
            dd0 = __shfl(pst, ee & 255) + ld_i32(tok_slot + 2 * rowl); dd1 = __shfl(pst, ee >> 8) + ld_i32(tok_slot + 2 * rowl + 1); gg0 = ld_f32(tok_gate + 2 * rowl); gg1 = ld_f32(tok_gate + 2 * rowl + 1); sm_ = ld_f32(lnst + 2 * rowl); sr_ = ld_f32(lnst + 2 * rowl + 1); }
        u32x2 nx[2][4]; unsigned ny0[2][4], ny1[2][4];
#define LN_ISSUE(i0) do { _Pragma("unroll") for (int rr = 0; rr < 2; ++rr) { const int row = W0 + (i0) + rr; const u32x2* xr = (const u32x2*)(xs + (size_t)row * D) + lane; \
            _Pragma("unroll") for (int j = 0; j < 4; ++j) nx[rr][j] = xr[64 * j]; \
            if (MODE != 0) { const int d0 = __builtin_amdgcn_readlane(dd0, (i0) + rr), d1 = __builtin_amdgcn_readlane(dd1, (i0) + rr); \
                const unsigned* y0 = (const unsigned*)(yb + (size_t)d0 * D) + lane; const unsigned* y1 = (const unsigned*)(yb + (size_t)d1 * D) + lane; \
                _Pragma("unroll") for (int j = 0; j < 4; ++j) { ny0[rr][j] = y0[64 * j]; ny1[rr][j] = y1[64 * j]; } } } } while (0)
        LN_ISSUE(0);
#pragma unroll 1
        for (int ii = 0; ii < 16; ii += 2) {
            f32x4 v[2][4];
#pragma unroll
            for (int rr = 0; rr < 2; ++rr) {
#pragma unroll
                for (int j = 0; j < 4; ++j) { v[rr][j][0] = bf_lo(nx[rr][j].x); v[rr][j][1] = bf_hi(nx[rr][j].x); v[rr][j][2] = bf_lo(nx[rr][j].y); v[rr][j][3] = bf_hi(nx[rr][j].y); }
                if (MODE != 0) {
                    const float g0 = rdlane(gg0, ii + rr) * (1.0f / SC_Y), g1 = rdlane(gg1, ii + rr) * (1.0f / SC_Y);
                    const float m_ = rdlane(sm_, ii + rr), r_ = rdlane(sr_, ii + rr) * ALPHA;
#pragma unroll
                    for (int j = 0; j < 4; ++j) { const f32x2 p0 = __builtin_amdgcn_cvt_pk_f32_fp8((int)ny0[rr][j], false), p1 = __builtin_amdgcn_cvt_pk_f32_fp8((int)ny0[rr][j], true);
                        const f32x2 q0 = __builtin_amdgcn_cvt_pk_f32_fp8((int)ny1[rr][j], false), q1 = __builtin_amdgcn_cvt_pk_f32_fp8((int)ny1[rr][j], true);
                        f32x4 f; f[0] = g0 * p0[0] + g1 * q0[0]; f[1] = g0 * p0[1] + g1 * q0[1]; f[2] = g0 * p1[0] + g1 * q1[0]; f[3] = g0 * p1[1] + g1 * q1[1];
                        const f32x4 gm4 = *((const LAS f32x4*)gmx + lane + 64 * j), bm4 = *((const LAS f32x4*)bmx + lane + 64 * j);
                        v[rr][j] = (v[rr][j] - m_) * r_ * gm4 + bm4 + f; }
                }
            }
            if (ii + 2 < 16) LN_ISSUE(ii + 2);
#pragma unroll
            for (int rr = 0; rr < 2; ++rr) {
                float s = 0.f;
#pragma unroll
                for (int j = 0; j < 4; ++j) s += (v[rr][j][0] + v[rr][j][1]) + (v[rr][j][2] + v[rr][j][3]);
                const float mean = wave_sum(s) * (1.0f / D); float q = 0.f;
#pragma unroll
                for (int j = 0; j < 4; ++j) { v[rr][j] = v[rr][j] - mean; q += (v[rr][j][0] * v[rr][j][0] + v[rr][j][1] * v[rr][j][1]) + (v[rr][j][2] * v[rr][j][2] + v[rr][j][3] * v[rr][j][3]); }
                const float rstd = __builtin_amdgcn_rsqf(wave_sum(q) * (1.0f / D) + LN_EPS);
                const int row = W0 + ii + rr;
                u32x2* bo = (u32x2*)(xs + (size_t)row * D) + lane;
                if (MODE == 0 && lane == 0) { lnst[2 * row] = mean; lnst[2 * row + 1] = rstd; }
#pragma unroll
                for (int j = 0; j < 4; ++j) { v[rr][j] = v[rr][j] * rstd * gv[j] + bv[j];
                    if (MODE == 2) { ((f32x4*)(a.out + (size_t)row * D))[lane + 64 * j] = v[rr][j]; }
                    else if (MODE == 1) { u32x2 w; w.x = cvt_pk_bf16(v[rr][j][0], v[rr][j][1]); w.y = cvt_pk_bf16(v[rr][j][2], v[rr][j][3]); bo[64 * j] = w; }
                    if (MODE == 0) { ((unsigned*)(x8 + (size_t)row * D))[lane + 64 * j] = pk4_fp8_sat(v[rr][j][0], v[rr][j][1], v[rr][j][2], v[rr][j][3]); }
                    if (MODE == 1) { ((unsigned*)(x8 + (size_t)row * D))[lane + 64 * j] = pk4_i8(v[rr][j][0], v[rr][j][1], v[rr][j][2], v[rr][j][3], SI_X); } }
            }
            if (MODE != 2) {
                float acc[2][16];
#pragma unroll
                for (int e = 0; e < 16; ++e) {
                    f32x4 w[4];
#pragma unroll
                    for (int j = 0; j < 4; ++j) w[j] = *((const LAS f32x4*)(Wx + e * LN_WXS) + lane + 64 * j);
                    f32x2 sA[2] = {{0.f, 0.f}, {0.f, 0.f}}, sB[2] = {{0.f, 0.f}, {0.f, 0.f}};
#pragma unroll
                    for (int j = 0; j < 4; ++j)
#pragma unroll
                        for (int rr = 0; rr < 2; ++rr) { sA[rr] = __builtin_elementwise_fma(__builtin_shufflevector(v[rr][j], v[rr][j], 0, 1), __builtin_shufflevector(w[j], w[j], 0, 1), sA[rr]);
                                                         sB[rr] = __builtin_elementwise_fma(__builtin_shufflevector(v[rr][j], v[rr][j], 2, 3), __builtin_shufflevector(w[j], w[j], 2, 3), sB[rr]); }
#pragma unroll
                    for (int rr = 0; rr < 2; ++rr) { const f32x2 t2 = sA[rr] + sB[rr]; acc[rr][e] = t2[0] + t2[1]; }
                    asm volatile("" : "+v"(acc[0][e]), "+v"(acc[1][e]));
                }
#pragma unroll
                for (int rr = 0; rr < 2; ++rr) {
                    float t4[4]; reduce16b(acc[rr], t4);
                    const int rl = F.wave * 16 + ii + rr;
                    if ((lane & 15) == 15) *(LAS f32x4*)(gates + rl * 16 + 4 * (lane >> 4)) = (f32x4){t4[0], t4[1], t4[2], t4[3]};
                }
            }
        }
#undef LN_ISSUE
        if (MODE == 0) {
            LDS_WAIT(); asm volatile("" ::: "memory");
            if (lane < 16) {
                const int rl = F.wave * 16 + lane;
                float lg[16];
#pragma unroll
                for (int q = 0; q < 4; ++q) { const f32x4 t4 = *(const LAS f32x4*)(gates + rl * 16 + 4 * q); lg[4 * q] = t4[0]; lg[4 * q + 1] = t4[1]; lg[4 * q + 2] = t4[2]; lg[4 * q + 3] = t4[3]; }
                float mx = lg[0];
#pragma unroll
                for (int e = 1; e < 16; ++e) mx = fmaxf(mx, lg[e]);
                float sum = 0.f;
#pragma unroll
                for (int e = 0; e < 16; ++e) { lg[e] = __expf(lg[e] - mx); sum += lg[e]; }
                const float inv = 1.0f / sum;
                int gbest = 0; float gsbest = -3.0e38f; float w4[4], p4[4];
#pragma unroll
                for (int i = 0; i < 4; ++i) { w4[i] = 0.f; p4[i] = 0.f; }
#pragma unroll
                for (int g = 0; g < 4; ++g) {
                    float pp[4], ss[4];
#pragma unroll
                    for (int i = 0; i < 4; ++i) { pp[i] = lg[4 * g + i] * inv; ss[i] = pp[i] + a.in[13][4 * g + i]; }
                    const float mx1 = fmaxf(fmaxf(ss[0], ss[1]), fmaxf(ss[2], ss[3]));
                    const float a01 = fminf(ss[0], ss[1]), b01 = fmaxf(ss[0], ss[1]), a23 = fminf(ss[2], ss[3]), b23 = fmaxf(ss[2], ss[3]);
                    const float mx2 = fmaxf(fminf(b01, b23), fmaxf(a01, a23));
                    const float gs = mx1 + mx2;
                    const bool better = gs > gsbest;
                    gsbest = better ? gs : gsbest; gbest = better ? g : gbest;
#pragma unroll
                    for (int i = 0; i < 4; ++i) { w4[i] = better ? ss[i] : w4[i]; p4[i] = better ? pp[i] : p4[i]; }
                }
                int i0 = 0; float b0 = w4[0];
#pragma unroll
                for (int i = 1; i < 4; ++i) { const bool bt = w4[i] > b0; b0 = bt ? w4[i] : b0; i0 = bt ? i : i0; }
                int i1 = 0; float b1 = -3.0e38f;
#pragma unroll
                for (int i = 0; i < 4; ++i) { const bool bt = (i != i0) && (w4[i] > b1); b1 = bt ? w4[i] : b1; i1 = bt ? i : i1; }
                const float q0 = i0 == 0 ? p4[0] : i0 == 1 ? p4[1] : i0 == 2 ? p4[2] : p4[3];
                const float q1 = i1 == 0 ? p4[0] : i1 == 1 ? p4[1] : i1 == 2 ? p4[2] : p4[3];
                const float gi = 1.0f / (q0 + q1);
                const int e0 = gbest * 4 + i0, e1 = gbest * 4 + i1;
                const int r0 = __hip_atomic_fetch_add(cnt + e0, 1, __ATOMIC_RELAXED, __HIP_MEMORY_SCOPE_WORKGROUP);
                const int r1 = __hip_atomic_fetch_add(cnt + e1, 1, __ATOMIC_RELAXED, __HIP_MEMORY_SCOPE_WORKGROUP);
                rowi[rl * 4 + 0] = e0; rowi[rl * 4 + 1] = e1; rowi[rl * 4 + 2] = r0; rowi[rl * 4 + 3] = r1;
                rowg[rl * 2 + 0] = q0 * gi; rowg[rl * 2 + 1] = q1 * gi;
            }
        }
        __syncthreads();
        if (MODE == 0) {
            unsigned* gcnt = F.ctl + CW_CNT + layer * 16 * 64;
            if (F.tid < 16) cnt[16 + F.tid] = (int)atomicAdd(gcnt + F.tid * 64, (unsigned)cnt[F.tid]);
            __syncthreads();
            if (F.tid < 128) {
                const int t = R0 + F.tid; const int e0 = rowi[F.tid * 4], e1 = rowi[F.tid * 4 + 1];
                ((int*)(F.ws + WS_TOK_E))[t] = e0 | (e1 << 8);
                const int s0 = cnt[16 + e0] + rowi[F.tid * 4 + 2], s1 = cnt[16 + e1] + rowi[F.tid * 4 + 3];
                ((int*)(F.ws + WS_TOK_SLOT))[2 * t] = s0; ((int*)(F.ws + WS_TOK_SLOT))[2 * t + 1] = s1;
                ((int*)(F.ws + WS_SLOT_TOK))[e0 * 32768 + s0] = t; ((int*)(F.ws + WS_SLOT_TOK))[e1 * 32768 + s1] = t;
                ((float*)(F.ws + WS_TOK_GATE))[2 * t] = rowg[F.tid * 2]; ((float*)(F.ws + WS_TOK_GATE))[2 * t + 1] = rowg[F.tid * 2 + 1];
            }
        }
        if (MODE == 1) {
            const int h = F.wave;
#pragma unroll
            for (int cc = 0; cc < 2; ++cc) {
                const int rl = cc * 64 + lane, t = R0 + rl;
                const float li = gates[rl * 16 + h] + a.in[5][h], fp = gates[rl * 16 + 8 + h] + a.in[5][8 + h];
                const float lf = fminf(fp, 0.f) - log1pf(expf(-fabsf(fp)));
                float b = lf;
#pragma unroll
                for (int o = 1; o < 64; o <<= 1) { const float tt = __shfl_up(b, o); if (lane >= o) b += tt; }
                const float ib = li - b; float cm = ib;
#pragma unroll
                for (int o = 1; o < 64; o <<= 1) { const float tt = __shfl_up(cm, o); if (lane >= o) cm = fmaxf(cm, tt); }
                ((float*)(F.ws + WS_GB))[t * 8 + h] = b; ((float*)(F.ws + WS_GIB))[t * 8 + h] = ib; ((float*)(F.ws + WS_GCM))[t * 8 + h] = cm;
                if (lane == 63) { const int bb = t / SEQ, c = (t % SEQ) / 64; f32x2 st; st.x = b; st.y = cm; ((f32x2*)(F.ws + WS_CHST))[(bb * 8 + h) * 64 + c] = st; }
            }
        }
        __syncthreads();
    }
}

__device__ __forceinline__ int build_tile_table(const Ctx& F, int layer) {
    int nt, mt; const int pstart = expert_pstart(F, layer, nt, mt);
    LAS unsigned char* te = F.lds + TILE_E_OFF;
    if (F.wave == 0 && F.lane < 16) { const int t0 = pstart >> 8; for (int i = 0; i < mt; ++i) te[t0 + i] = (unsigned char)F.lane;
        LAS int* ti = (LAS int*)(F.lds + TINFO_OFF); ti[F.lane] = t0; ti[16 + F.lane] = (int)__hip_atomic_load(F.ctl + CW_CNT + layer * 16 * 64 + F.lane * 64, __ATOMIC_RELAXED, __HIP_MEMORY_SCOPE_AGENT); }
    __syncthreads();
    return nt;
}

__device__ __forceinline__ int offv_d(int row, int ch) { return 256 * row + 16 * (ch ^ (((row & 3) << 2) | (((row >> 2) & 1) << 1) | ((row >> 3) & 1))); }
__device__ __forceinline__ int offk_b(int row, int ch) { return 128 * row + 16 * (ch ^ ((((row >> 1) & 1) << 1) | (((row >> 3) & 1) << 2))); }
__device__ __forceinline__ int offv_b(int row, int ch) { return 256 * row + 16 * (ch ^ (((row & 3) << 2) | ((row >> 2) & 3))); }
constexpr int M6_MST = MISC_OFF + 1024  , M6_CH = MISC_OFF + 1152  , M6_OFF = MISC_OFF + 1664  , M6_PM = MISC_OFF + 1920  ,
              M6_BL = MISC_OFF + 2176  , M6_CML = MISC_OFF + 2240  ;
__device__ __forceinline__ void ml256_setup(const Ctx& F, int bh) {
    LAS float* mst = (LAS float*)(F.lds + M6_MST); LAS f32x2* ch = (LAS f32x2*)(F.lds + M6_CH); LAS float* offs = (LAS float*)(F.lds + M6_OFF); LAS float* pms = (LAS float*)(F.lds + M6_PM);
    LAS float* bl = (LAS float*)(F.lds + M6_BL); LAS float* cml = (LAS float*)(F.lds + M6_CML);
    __syncthreads();
    if (F.wave == 0) {
        const int lane = F.lane, sub = lane & 3, base = lane & ~3;
        const f32x2 st = ((const f32x2*)(F.ws + WS_CHST))[bh * 64 + lane]; ch[lane] = st;
        float off = 0.f, pm = -3.0e38f;
#pragma unroll
        for (int q = 0; q < 3; ++q) { const float bq = __shfl(st.x, base + q), cq = __shfl(st.y, base + q); if (q < sub) { pm = fmaxf(pm, cq - off); off += bq; } }
        offs[lane] = off; pms[lane] = pm;
        const float b256 = off + st.x, c256 = fmaxf(pm, st.y - off);
        if (sub == 3) { bl[lane >> 2] = b256; cml[lane >> 2] = c256; }
        float A = __shfl(b256, 4 * (lane & 15) + 3), B = A + __shfl(c256, 4 * (lane & 15) + 3);
#pragma unroll
        for (int o = 1; o < 16; o <<= 1) { const float Ap = __shfl_up(A, o), Bp = __shfl_up(B, o); if ((lane & 15) >= o) { B = fmaxf(Bp + A, B); A = Ap + A; } }
        if (lane < 16) { mst[lane + 1] = fmaxf(A, B); if (lane == 0) mst[0] = 0.f; }
    }
    __syncthreads();
}
__device__ __forceinline__ void ml_stage_b256(const Ctx& F) {
    const bf16_t* proj = (const bf16_t*)(F.ws + WS_BUFC); bf16_t* Dc = (bf16_t*)(F.ws + WS_BUFB); float* Dn = (float*)(F.ws + WS_DN);
    const float* gib = (const float*)(F.ws + WS_GIB);
    LAS float* mst = (LAS float*)(F.lds + M6_MST); LAS float* offs = (LAS float*)(F.lds + M6_OFF); LAS float* cml = (LAS float*)(F.lds + M6_CML);
    const int lane = F.lane, fr = lane & 15, fq = lane >> 4, w = F.wave, pr = w >> 1, wh = w & 1, pt = wh * 64 + lane;
    LAS unsigned char* vimg = F.lds + pr * 32768; LAS unsigned char* kimg = vimg + 16384;
    const int tq = fr >> 2, tp1 = (fr & 3) >> 1, tb = 8 * (fr & 1);
    for (int grp = F.bid; grp < 256; grp += F.G) {
        const int bh = grp >> 2, bb = bh >> 3, h = bh & 7, C6 = 4 * (grp & 3) + pr;
        ml256_setup(F, bh);
        const float Ml = fmaxf(mst[C6], cml[C6]);
        f32x4 acc[4][4], accn[4];
#pragma unroll
        for (int a = 0; a < 4; ++a) { accn[a] = (f32x4){0.f, 0.f, 0.f, 0.f};
#pragma unroll
            for (int b = 0; b < 4; ++b) acc[a][b] = (f32x4){0.f, 0.f, 0.f, 0.f}; }
#pragma unroll 1
        for (int it = 0; it < 4; ++it) {
            const int c = 4 * C6 + it, t0 = bb * SEQ + c * 64;
            u32x2 vreg[8]; u32x4 kreg[4]; float gr[4];
#pragma unroll
            for (int i = 0; i < 8; ++i) { const int idx = pt + 128 * i; vreg[i] = *(const u32x2*)(F.ws + WS_V8 + (size_t)(t0 + (idx >> 4)) * 1024 + h * 128 + 8 * (idx & 15)); }
#pragma unroll
            for (int i = 0; i < 4; ++i) { const int idx = pt + 128 * i; kreg[i] = *(const u32x4*)(proj + (size_t)(t0 + (idx >> 3)) * 3072 + 512 + h * 64 + 8 * (idx & 7)); gr[i] = gib[(size_t)(t0 + (idx >> 3)) * 8 + h]; }
            __syncthreads();
            const float sh = offs[c] + Ml;
#pragma unroll
            for (int i = 0; i < 8; ++i) { const int idx = pt + 128 * i; *(LAS u32x4*)(vimg + offv_b(idx >> 4, idx & 15)) = u8x8_bf16(vreg[i], 1.0f / SV8); }
#pragma unroll
            for (int i = 0; i < 4; ++i) { const int idx = pt + 128 * i; const float g = __expf(gr[i] - sh); u32x4 o;
#pragma unroll
                for (int q = 0; q < 4; ++q) o[q] = cvt_pk_bf16(bf_lo(kreg[i][q]) * g, bf_hi(kreg[i][q]) * g);
                *(LAS u32x4*)(kimg + offk_b(idx >> 3, idx & 7)) = o; }
            __syncthreads();
            bf16x8 ka[4][2];
#pragma unroll
            for (int td = 0; td < 4; ++td)
#pragma unroll
                for (int s2 = 0; s2 < 2; ++s2) { const int row = 32 * s2 + 8 * fq + tq;
                    const s16x4 lo = __builtin_amdgcn_ds_read_tr16_b64_v4i16((LAS s16x4*)(kimg + offk_b(row, 2 * td + tp1) + tb));
                    const s16x4 hi = __builtin_amdgcn_ds_read_tr16_b64_v4i16((LAS s16x4*)(kimg + offk_b(row + 4, 2 * td + tp1) + tb));
                    ka[td][s2] = __builtin_shufflevector(lo, hi, 0, 1, 2, 3, 4, 5, 6, 7); }
#pragma unroll
            for (int tvl = 0; tvl < 4; ++tvl) { const int tv = 4 * wh + tvl;
                bf16x8 vb[2];
#pragma unroll
                for (int s2 = 0; s2 < 2; ++s2) { const int row = 32 * s2 + 8 * fq + tq;
                    const s16x4 lo = __builtin_amdgcn_ds_read_tr16_b64_v4i16((LAS s16x4*)(vimg + offv_b(row, 2 * tv + tp1) + tb));
                    const s16x4 hi = __builtin_amdgcn_ds_read_tr16_b64_v4i16((LAS s16x4*)(vimg + offv_b(row + 4, 2 * tv + tp1) + tb));
                    vb[s2] = __builtin_shufflevector(lo, hi, 0, 1, 2, 3, 4, 5, 6, 7); }
#pragma unroll
                for (int td = 0; td < 4; ++td)
#pragma unroll
                    for (int s2 = 0; s2 < 2; ++s2) acc[tvl][td] = __builtin_amdgcn_mfma_f32_16x16x32_bf16(ka[td][s2], vb[s2], acc[tvl][td], 0, 0, 0);
            }
            if (wh == 0) {
                const short one = (fr == 0) ? (short)0x3F80 : (short)0; const bf16x8 ones = {one, one, one, one, one, one, one, one};
#pragma unroll
                for (int td = 0; td < 4; ++td)
#pragma unroll
                    for (int s2 = 0; s2 < 2; ++s2) accn[td] = __builtin_amdgcn_mfma_f32_16x16x32_bf16(ka[td][s2], ones, accn[td], 0, 0, 0);
            }
        }
        bf16_t* dst = Dc + ((size_t)(bh * 16 + C6) * 8192);
#pragma unroll
        for (int tvl = 0; tvl < 4; ++tvl)
#pragma unroll
            for (int td = 0; td < 4; ++td) { const int tv = 4 * wh + tvl; u32x2 wv; wv.x = cvt_pk_bf16_c(acc[tvl][td][0], acc[tvl][td][1]); wv.y = cvt_pk_bf16_c(acc[tvl][td][2], acc[tvl][td][3]);
                *(u32x2*)(dst + (16 * tv + fr) * 64 + 16 * td + 4 * fq) = wv; }
        if (wh == 0 && fr == 0) {
#pragma unroll
            for (int td = 0; td < 4; ++td) *(f32x4*)(Dn + (size_t)(bh * 16 + C6) * 64 + 16 * td + 4 * fq) = accn[td];
        }
    }
}
__device__ __forceinline__ void ml_stage_c256(const Ctx& F) {
    const u32x2* Dc = (const u32x2*)(F.ws + WS_BUFB); u32x2* Cst = (u32x2*)(F.ws + WS_CST);
    const f32x4* Dn = (const f32x4*)(F.ws + WS_DN); f32x4* Nst = (f32x4*)(F.ws + WS_NST);
    LAS float* mst = (LAS float*)(F.lds + M6_MST); LAS float* cml = (LAS float*)(F.lds + M6_CML);
    for (int grp = F.bid; grp < 256; grp += F.G) {
        const int bh = grp >> 2, idx = (grp & 3) * 512 + F.tid;
        ml256_setup(F, bh);
        const bool ncarry = ((grp & 3) == 0) && F.tid < 16;
        f32x4 st = (f32x4){0.f, 0.f, 0.f, 0.f}, sn = st;
        f32x4 d[16], dn[16];
#pragma unroll
        for (int i = 0; i < 16; ++i) { const u32x2 dw = Dc[(size_t)(bh * 16 + i) * 2048 + idx]; d[i] = (f32x4){bf_lo(dw.x), bf_hi(dw.x), bf_lo(dw.y), bf_hi(dw.y)}; if (ncarry) dn[i] = Dn[(size_t)(bh * 16 + i) * 16 + F.tid]; }
#pragma unroll
        for (int i = 0; i < 16; ++i) { const float m = mst[i]; const float gs = __expf(m - fmaxf(m, cml[i]));
            u32x2 wv; wv.x = cvt_pk_bf16(st[0], st[1]); wv.y = cvt_pk_bf16(st[2], st[3]); Cst[(size_t)(bh * 16 + i) * 2048 + idx] = wv;
            st = st * gs + d[i];
            if (ncarry) { Nst[(size_t)(bh * 16 + i) * 16 + F.tid] = sn; sn = sn * gs + dn[i]; } }
    }
}
constexpr int D6_V = 0  , D6_K = 65536  , D6_C = 98304  ,
              D6_IB = 114688  , D6_CM = 115712, D6_BB = 116736, D6_NS = 117760  , D6_ST = 118784  ;
__device__ __forceinline__ void ml_stage_d256(const Ctx& F, const float* norm_g) {
    const bf16_t* proj = (const bf16_t*)(F.ws + WS_BUFC); const bf16_t* Cst = (const bf16_t*)(F.ws + WS_CST); const float* Nst = (const float*)(F.ws + WS_NST);
    unsigned char* hmix8 = (unsigned char*)(F.ws + WS_HMIX);
    const float* gib = (const float*)(F.ws + WS_GIB); const float* gcm = (const float*)(F.ws + WS_GCM); const float* gb = (const float*)(F.ws + WS_GB);
    LAS float* mst = (LAS float*)(F.lds + M6_MST); LAS float* offs = (LAS float*)(F.lds + M6_OFF); LAS float* pms = (LAS float*)(F.lds + M6_PM);
    LAS float* ibs = (LAS float*)(F.lds + D6_IB); LAS float* cms = (LAS float*)(F.lds + D6_CM); LAS float* bbs = (LAS float*)(F.lds + D6_BB); LAS float* ns = (LAS float*)(F.lds + D6_NS);
    LAS unsigned char* vt = F.lds + D6_V; LAS unsigned char* kimg = F.lds + D6_K; LAS unsigned char* csl = F.lds + D6_C;
    const int lane = F.lane, fr = lane & 15, fq = lane >> 4, w = F.wave, tid = F.tid;
    LAS unsigned char* stg = F.lds + D6_ST + w * 4224;
#ifndef D6_REPS
#define D6_REPS 1
#endif
#pragma unroll 1
    for (int rep_ = 0; rep_ < D6_REPS; ++rep_)
    for (int grp = F.bid; grp < 256; grp += F.G) {
        const int bh = grp >> 2, bb = bh >> 3, h = bh & 7;
        ml256_setup(F, bh);
        u32x2 vreg[8]; u32x4 kreg[4], creg[2]; float s_ib = 0.f, s_cm = 0.f, s_bb = 0.f, s_ns = 0.f;
#define D6_ISSUE(itn) do { const int C6n = 4 * (grp & 3) + (itn), t0n = bb * SEQ + C6n * 256; const bf16_t* csn = Cst + (size_t)(bh * 16 + C6n) * 8192; \
            _Pragma("unroll") for (int i = 0; i < 8; ++i) { const int idx = tid + 512 * i; vreg[i] = *(const u32x2*)(F.ws + WS_V8 + (size_t)(t0n + (idx >> 4)) * 1024 + h * 128 + 8 * (idx & 15)); } \
            _Pragma("unroll") for (int i = 0; i < 4; ++i) { const int idx = tid + 512 * i; kreg[i] = *(const u32x4*)(proj + (size_t)(t0n + (idx >> 3)) * 3072 + 512 + h * 64 + 8 * (idx & 7)); } \
            _Pragma("unroll") for (int i = 0; i < 2; ++i) { const int idx = tid + 512 * i; creg[i] = *(const u32x4*)(csn + (size_t)(idx >> 3) * 64 + 8 * (idx & 7)); } \
            if (tid < 256) { s_ib = gib[(size_t)(t0n + tid) * 8 + h]; s_cm = gcm[(size_t)(t0n + tid) * 8 + h]; s_bb = gb[(size_t)(t0n + tid) * 8 + h]; } \
            if (tid < 64) s_ns = Nst[(size_t)(bh * 16 + C6n) * 64 + tid]; } while (0)
        D6_ISSUE(0);
#pragma unroll 1
        for (int it = 0; it < 4; ++it) {
            const int C6 = 4 * (grp & 3) + it, t0 = bb * SEQ + C6 * 256;
            __syncthreads();
#pragma unroll
            for (int i = 0; i < 8; ++i) { const int idx = tid + 512 * i; *(LAS u32x4*)(vt + offv_d(idx >> 4, idx & 15)) = u8x8_bf16(vreg[i], 1.0f / SV8); }
#pragma unroll
            for (int i = 0; i < 4; ++i) { const int idx = tid + 512 * i; *(LAS u32x4*)(kimg + pg8::lds_byte(idx >> 3, 8 * (idx & 7))) = kreg[i]; }
#pragma unroll
            for (int i = 0; i < 2; ++i) { const int idx = tid + 512 * i; *(LAS u32x4*)(csl + pg8::lds_byte(idx >> 3, 8 * (idx & 7))) = creg[i]; }
            if (tid < 256) { const int c64 = 4 * C6 + (tid >> 6); const float off = offs[c64], pm = pms[c64]; ibs[tid] = s_ib - off; cms[tid] = fmaxf(pm, s_cm - off); bbs[tid] = s_bb + off; }
            if (tid < 64) ns[tid] = s_ns;
            __syncthreads();
            if (it + 1 < 4) D6_ISSUE(it + 1);
            const float mc = mst[C6];
#pragma unroll 1
            for (int pass = 0; pass < 2; ++pass) {
                const int tl = pass ? 15 - w : w, l = 16 * tl + fr;
                bf16x8 qc[2];
#pragma unroll
                for (int s2 = 0; s2 < 2; ++s2) qc[s2] = *(const bf16x8*)(proj + (size_t)(t0 + l) * 3072 + h * 64 + 32 * s2 + 8 * fq);
                u32x2 opre[4];
#pragma unroll
                for (int k = 0; k < 4; ++k) opre[k] = *(const u32x2*)(F.ws + WS_O8 + (size_t)(t0 + 16 * tl + 4 * k + fq) * 1024 + h * 128 + 8 * fr);
                const float Mrow = fmaxf(mc, cms[l]);
                const float wint = __expf(mc - Mrow);
                f32x4 an[8];
#pragma unroll
                for (int tv = 0; tv < 8; ++tv) an[tv] = (f32x4){0.f, 0.f, 0.f, 0.f};
                f32x4 rs4 = {0.f, 0.f, 0.f, 0.f};
#pragma unroll 1
                for (int kk = 0; kk <= (tl >> 1); ++kk) {
                    f32x4 sa[2];
#pragma unroll
                    for (int u = 0; u < 2; ++u) { sa[u] = (f32x4){0.f, 0.f, 0.f, 0.f}; const int tr = 2 * kk + u;
#pragma unroll
                        for (int s2 = 0; s2 < 2; ++s2) { const bf16x8 kf = *(const LAS bf16x8*)(kimg + pg8::lds_byte(16 * tr + fr, 32 * s2 + 8 * fq));
                            sa[u] = __builtin_amdgcn_mfma_f32_16x16x32_bf16(kf, qc[s2], sa[u], 0, 0, 0); }
                        const f32x4 ibv = *(const LAS f32x4*)(ibs + 16 * tr + 4 * fq);
                        const f32x4 ea = ibv * 1.44269504089f - Mrow * 1.44269504089f;
                        f32x4 p4;
#pragma unroll
                        for (int j = 0; j < 4; ++j) { const int r = 16 * tr + 4 * fq + j; p4[j] = (r <= l) ? __builtin_amdgcn_exp2f(ea[j]) : 0.f; }
                        sa[u] = sa[u] * p4; rs4 = rs4 + sa[u]; }
                    u32x4 pk; pk.x = cvt_pk_bf16(sa[0][0], sa[0][1]); pk.y = cvt_pk_bf16(sa[0][2], sa[0][3]); pk.z = cvt_pk_bf16(sa[1][0], sa[1][1]); pk.w = cvt_pk_bf16(sa[1][2], sa[1][3]);
                    const bf16x8 af = __builtin_bit_cast(bf16x8, pk);
                    const int trow = 32 * kk + 4 * fq + (fr >> 2), tb = 8 * (fr & 1);
#pragma unroll
                    for (int tv = 0; tv < 8; ++tv) { const int tch = 2 * tv + ((fr & 3) >> 1);
                        const s16x4 lo = __builtin_amdgcn_ds_read_tr16_b64_v4i16((LAS s16x4*)(vt + offv_d(trow, tch) + tb));
                        const s16x4 hi = __builtin_amdgcn_ds_read_tr16_b64_v4i16((LAS s16x4*)(vt + offv_d(trow + 16, tch) + tb));
                        const bf16x8 vf = __builtin_shufflevector(lo, hi, 0, 1, 2, 3, 4, 5, 6, 7);
                        an[tv] = __builtin_amdgcn_mfma_f32_16x16x32_bf16(vf, af, an[tv], 0, 0, 0); }
                }
                float rsum = (rs4[0] + rs4[1]) + (rs4[2] + rs4[3]);
                rsum += __shfl_xor(rsum, 16); rsum += __shfl_xor(rsum, 32);
                float qn = 0.f;
#pragma unroll
                for (int s2 = 0; s2 < 2; ++s2) { const f32x4 n0 = *(const LAS f32x4*)(ns + 32 * s2 + 8 * fq), n1 = *(const LAS f32x4*)(ns + 32 * s2 + 8 * fq + 4);
                    const u32x4 qw = __builtin_bit_cast(u32x4, qc[s2]);
                    qn += bf_lo(qw[0]) * n0[0] + bf_hi(qw[0]) * n0[1] + bf_lo(qw[1]) * n0[2] + bf_hi(qw[1]) * n0[3] + bf_lo(qw[2]) * n1[0] + bf_hi(qw[2]) * n1[1] + bf_lo(qw[3]) * n1[2] + bf_hi(qw[3]) * n1[3]; }
                qn += __shfl_xor(qn, 16); qn += __shfl_xor(qn, 32);
                const float den = rsum + wint * qn;
                const float mt = bbs[l] + Mrow;
                const float rden = __builtin_amdgcn_rcpf(fmaxf(fabsf(den), __expf(-mt)));
                unsigned hp[8][2]; f32x4 sq4 = {0.f, 0.f, 0.f, 0.f};
#pragma unroll
                for (int tv = 0; tv < 8; ++tv) {
                    f32x4 ac = (f32x4){0.f, 0.f, 0.f, 0.f};
#pragma unroll
                    for (int s2 = 0; s2 < 2; ++s2) { const bf16x8 cf = *(const LAS bf16x8*)(csl + pg8::lds_byte(16 * tv + fr, 32 * s2 + 8 * fq));
                        ac = __builtin_amdgcn_mfma_f32_16x16x32_bf16(cf, qc[s2], ac, 0, 0, 0); }
                    const f32x4 hh = (an[tv] + ac * wint) * rden;
                    sq4 = __builtin_elementwise_fma(hh, hh, sq4);
                    hp[tv][0] = cvt_pk_bf16(hh[0], hh[1]); hp[tv][1] = cvt_pk_bf16(hh[2], hh[3]);
                }
                float sq = (sq4[0] + sq4[1]) + (sq4[2] + sq4[3]);
                sq += __shfl_xor(sq, 16); sq += __shfl_xor(sq, 32);
                const float rn = __builtin_amdgcn_rsqf(sq * (1.0f / 128.0f) + HN_EPS);
#pragma unroll
                for (int tv = 0; tv < 8; ++tv) { const f32x2 n0 = (f32x2){bf_lo(hp[tv][0]), bf_hi(hp[tv][0])} * rn, n1 = (f32x2){bf_lo(hp[tv][1]), bf_hi(hp[tv][1])} * rn; u32x2 wv; wv.x = cvt_pk_bf16(n0[0], n0[1]); wv.y = cvt_pk_bf16(n1[0], n1[1]);
                    *(LAS u32x2*)(stg + fr * 264 + (16 * tv + 4 * fq) * 2) = wv; }
                const f32x4 ng0 = *(const f32x4*)(norm_g + h * 128 + 8 * fr), ng1 = *(const f32x4*)(norm_g + h * 128 + 8 * fr + 4);
                LDS_WAIT(); asm volatile("" ::: "memory");
#pragma unroll
                for (int k = 0; k < 4; ++k) { const int row = 4 * k + fq;
                    const u32x2 h0 = *(const LAS u32x2*)(stg + row * 264 + 16 * fr), h1 = *(const LAS u32x2*)(stg + row * 264 + 16 * fr + 8);
                    const u32x2 op = opre[k]; constexpr float c1 = -1.44269504089f / SO8, c0 = 1.44269504089f * 128.0f / SO8;
#define D6_SG(w_, k_) __builtin_amdgcn_rcpf(1.0f + __builtin_amdgcn_exp2f(__builtin_fmaf(ubf(w_, k_), c1, c0)))
                    const f32x2 f01 = (f32x2){bf_lo(h0.x), bf_hi(h0.x)} * (f32x2){ng0[0], ng0[1]} * (f32x2){D6_SG(op.x, 0), D6_SG(op.x, 1)} * SC_X;
                    const f32x2 f23 = (f32x2){bf_lo(h0.y), bf_hi(h0.y)} * (f32x2){ng0[2], ng0[3]} * (f32x2){D6_SG(op.x, 2), D6_SG(op.x, 3)} * SC_X;
                    const f32x2 f45 = (f32x2){bf_lo(h1.x), bf_hi(h1.x)} * (f32x2){ng1[0], ng1[1]} * (f32x2){D6_SG(op.y, 0), D6_SG(op.y, 1)} * SC_X;
                    const f32x2 f67 = (f32x2){bf_lo(h1.y), bf_hi(h1.y)} * (f32x2){ng1[2], ng1[3]} * (f32x2){D6_SG(op.y, 2), D6_SG(op.y, 3)} * SC_X;
#undef D6_SG
                    u32x2 o8; o8.x = pk4_fp8_sat(f01[0], f01[1], f23[0], f23[1]); o8.y = pk4_fp8_sat(f45[0], f45[1], f67[0], f67[1]);
                    *(u32x2*)(hmix8 + (size_t)(t0 + 16 * tl + row) * D + h * 128 + 8 * fr) = o8; }
                LDS_WAIT(); asm volatile("" ::: "memory");
            }
        }
        __syncthreads();
    }
#undef D6_ISSUE
}

constexpr int N_PHASES = 19;
__global__ void __launch_bounds__(NTHREADS, 2) fwd_kernel(Args args) {
    extern __shared__ __attribute__((aligned(16))) unsigned char lds_raw[];
    Ctx F;
    F.lds = (LAS unsigned char*)lds_raw; F.ws = args.ws; F.ctl = (unsigned*)(args.ws + WS_CTL);
    asm volatile("s_setreg_imm32_b32 hwreg(HW_REG_MODE, 23, 1), 1");
    F.tid = threadIdx.x; F.lane = F.tid & 63; F.wave = __builtin_amdgcn_readfirstlane(F.tid >> 6); F.G = gridDim.x; F.bid = blockIdx.x;
#define FRESH() do { int l_; asm volatile("v_mbcnt_lo_u32_b32 %0, -1, 0\n\tv_mbcnt_hi_u32_b32 %0, -1, %0" : "=v"(l_)); F.lane = l_; F.tid = F.wave * 64 + l_; } while (0)
    volatile LAS unsigned* MISC = (volatile LAS unsigned*)(F.lds + MISC_OFF);
    if (F.tid < 16) MISC[F.tid] = 0u;
    __syncthreads();
#if MK_PER_PHASE
    XcdBarrier bar; bar.bar = nullptr; bar.x = 0; bar.st = nullptr;
#define GRID_BAR() do { } while (0)
#else
    XcdBarrier bar = xcd_barrier_post(F.ctl + CW_BAR, MISC);
#define GRID_BAR() xcd_barrier(bar)
#endif
    const int lo = args.ph_lo, hi = args.ph_hi;
    int nt_keep = 0;
#ifdef PH_ONLY
#define IN(k) ((k) == PH_ONLY && lo <= (k) && (k) < hi)
#else
#define IN(k) (lo <= (k) && (k) < hi)
#endif
#define SEAM2(k, k2) do { if (IN(k) && IN(k2)) GRID_BAR(); } while (0)
#define SEAM(k) SEAM2(k, (k) + 1)
    bf16_t* const XB = (bf16_t*)(F.ws + WS_XB); bf16_t* const BUFB = (bf16_t*)(F.ws + WS_BUFB); bf16_t* const BUFC = (bf16_t*)(F.ws + WS_BUFC);

    if (IN(0)) { FRESH(); { p0_prologue(F, args); } if (REP_MASK >> 0 & 1) { GRID_BAR(); { p0_prologue(F, args); } } } SEAM(0);
    if (IN(1)) { FRESH(); pg8::Gemm g{XB, (const bf16_t*)(F.ws + WS_WC1), 1024, 0, F.lds + TILE_E_OFF, 0}; pg8::StaticOrder S; S.init(T / 256, 8, F.G, F.bid);
        pg8::EpiMul E{BUFB}; pg8::gemm_phase<pg8::EpiMul>(F.lds, g, S, E); if (REP_MASK >> 1 & 1) { GRID_BAR(); pg8::gemm_phase<pg8::EpiMul>(F.lds, g, S, E); } } SEAM(1);
    if (IN(2)) { FRESH(); pg8::Gemm g{XB, (const bf16_t*)(F.ws + WS_WC1) + (size_t)2048 * 1024, 1024, 0, F.lds + TILE_E_OFF, 0}; pg8::StaticOrder S; S.init(T / 256, 4, F.G, F.bid);
        pg8::EpiConvGate E{BUFB, args.in[2], BUFB + (size_t)T * D}; pg8::gemm_phase<pg8::EpiConvGate>(F.lds, g, S, E); if (REP_MASK >> 2 & 1) { GRID_BAR(); pg8::gemm_phase<pg8::EpiConvGate>(F.lds, g, S, E); } } SEAM(2);
    if (IN(3)) { FRESH(); pg8::Gemm g{BUFB + (size_t)T * D, (const bf16_t*)(F.ws + WS_WC2), 1024, 0, F.lds + TILE_E_OFF, 0}; pg8::StaticOrder S; S.init(T / 256, 4, F.G, F.bid);
        pg8::EpiResBf16 E{XB, ALPHA}; pg8::gemm_phase<pg8::EpiResBf16>(F.lds, g, S, E); } SEAM(3);
    if (IN(4)) { FRESH(); { ln_phase<0>(F, args, 0); } if (REP_MASK >> 4 & 1) { GRID_BAR(); { ln_phase<0>(F, args, 0); } } } SEAM2(4, 6);
    if (IN(6)) { FRESH(); const int nt = build_tile_table(F, 0); nt_keep = nt; pg8::Gemm g{(const bf16_t*)(F.ws + WS_X8), (const bf16_t*)(F.ws + WS_W13), 512, 1, F.lds + TILE_E_OFF, (size_t)3072 * 512, (const int*)(F.ws + WS_SLOT_TOK), (const LAS int*)(F.lds + TINFO_OFF), (LAS int*)(F.lds + GTAB_OFF)}; pg8::StaticOrder S; S.init(nt, 12, F.G, F.bid);
        pg8::EpiSwiGLU8 E{(unsigned char*)BUFC}; pg8::gemm_phase<pg8::EpiSwiGLU8, true, true, true>(F.lds, g, S, E); if (REP_MASK >> 6 & 1) { GRID_BAR(); pg8::gemm_phase<pg8::EpiSwiGLU8, true, true, true>(F.lds, g, S, E); } } SEAM(6);
    if (IN(7)) { FRESH(); const int nt = IN(6) ? nt_keep : build_tile_table(F, 0); pg8::Gemm g{BUFC, (const bf16_t*)(F.ws + WS_W2), 768, 1, F.lds + TILE_E_OFF, (size_t)1024 * 768}; pg8::StaticOrder S; S.init(nt, 4, F.G, F.bid);
        pg8::EpiFp8S E{(unsigned char*)BUFB, SC_INV * SC_Y}; pg8::gemm_phase<pg8::EpiFp8S, true>(F.lds, g, S, E); if (REP_MASK >> 7 & 1) { GRID_BAR(); pg8::gemm_phase<pg8::EpiFp8S, true>(F.lds, g, S, E); } } SEAM(7);
    if (IN(8)) { FRESH(); { ln_phase<1>(F, args, 0); } if (REP_MASK >> 8 & 1) { GRID_BAR(); { ln_phase<1>(F, args, 0); } } } SEAM(8);
    if (IN(9)) { FRESH();
        pg8::Gemm g{(const bf16_t*)(F.ws + WS_X8), (const bf16_t*)(F.ws + WS_WM1I8), 512, 0, F.lds + TILE_E_OFF, 0}; pg8::StaticOrder S; S.init(T / 256, 12, F.G, F.bid);
        pg8::EpiBf16SI8 E{BUFC, 3072, F.ws + WS_V8, F.ws + WS_O8}; pg8::gemm_phase<pg8::EpiBf16SI8, false, true, false, true>(F.lds, g, S, E); } SEAM(9);
    if (IN(10)) { FRESH(); { ml_stage_b256(F); } if (REP_MASK >> 10 & 1) { GRID_BAR(); { ml_stage_b256(F); } } } SEAM(10);
    if (IN(11)) { FRESH(); { ml_stage_c256(F); } if (REP_MASK >> 11 & 1) { GRID_BAR(); { ml_stage_c256(F); } } } SEAM(11);
    if (IN(12)) { FRESH(); { ml_stage_d256(F, args.in[6]); } if (REP_MASK >> 12 & 1) { GRID_BAR(); { ml_stage_d256(F, args.in[6]); } } } SEAM(12);
    if (IN(13)) { FRESH(); pg8::Gemm g{(const bf16_t*)(F.ws + WS_HMIX), (const bf16_t*)(F.ws + WS_WM2F8), 512, 0, F.lds + TILE_E_OFF, 0}; pg8::StaticOrder S; S.init(T / 256, 4, F.G, F.bid);
        pg8::EpiResBf16 E{XB, ALPHA, SC_INV}; pg8::gemm_phase<pg8::EpiResBf16, true>(F.lds, g, S, E); } SEAM(13);
    if (IN(14)) { FRESH(); { ln_phase<0>(F, args, 1); } if (REP_MASK >> 14 & 1) { GRID_BAR(); { ln_phase<0>(F, args, 1); } } } SEAM2(14, 16);
    if (IN(16)) { FRESH(); const int nt = build_tile_table(F, 1); nt_keep = nt; pg8::Gemm g{(const bf16_t*)(F.ws + WS_X8), (const bf16_t*)(F.ws + WS_W13) + (size_t)16 * 3072 * 512, 512, 1, F.lds + TILE_E_OFF, (size_t)3072 * 512, (const int*)(F.ws + WS_SLOT_TOK), (const LAS int*)(F.lds + TINFO_OFF), (LAS int*)(F.lds + GTAB_OFF)}; pg8::StaticOrder S; S.init(nt, 12, F.G, F.bid);
        pg8::EpiSwiGLU8 E{(unsigned char*)BUFC}; pg8::gemm_phase<pg8::EpiSwiGLU8, true, true, true>(F.lds, g, S, E); if (REP_MASK >> 16 & 1) { GRID_BAR(); pg8::gemm_phase<pg8::EpiSwiGLU8, true, true, true>(F.lds, g, S, E); } } SEAM(16);
    if (IN(17)) { FRESH(); const int nt = IN(16) ? nt_keep : build_tile_table(F, 1); pg8::Gemm g{BUFC, (const bf16_t*)(F.ws + WS_W2) + (size_t)16 * 1024 * 768, 768, 1, F.lds + TILE_E_OFF, (size_t)1024 * 768}; pg8::StaticOrder S; S.init(nt, 4, F.G, F.bid);
        pg8::EpiFp8S E{(unsigned char*)BUFB, SC_INV * SC_Y}; pg8::gemm_phase<pg8::EpiFp8S, true>(F.lds, g, S, E); if (REP_MASK >> 17 & 1) { GRID_BAR(); pg8::gemm_phase<pg8::EpiFp8S, true>(F.lds, g, S, E); } } SEAM(17);
    if (IN(18)) { FRESH(); { ln_phase<2>(F, args, 1); } if (REP_MASK >> 18 & 1) { GRID_BAR(); { ln_phase<2>(F, args, 1); } } }
#undef IN
#undef SEAM
#undef SEAM2
}

extern "C" void kernel_launch(void* const* d_in, const int* in_sizes, int n_in, void* d_out, int out_size, void* d_ws, size_t ws_size, hipStream_t stream) {
    static int grid = 0;
    if (grid == 0) {
        if (n_in != 17 || out_size != T * D || ws_size < WS_END) { fprintf(stderr, "kernel_launch: unexpected shapes (n_in %d, out %d, ws %zu)\n", n_in, out_size, ws_size); grid = -1; return; }
        int dev = 0, cus = 0;
        if (hipGetDevice(&dev) != hipSuccess || hipDeviceGetAttribute(&cus, hipDeviceAttributeMultiprocessorCount, dev) != hipSuccess) { grid = -1; return; }
        if (hipFuncSetAttribute((const void*)fwd_kernel, hipFuncAttributeMaxDynamicSharedMemorySize, LDS_BYTES) != hipSuccess) { fprintf(stderr, "kernel_launch: hipFuncSetAttribute failed\n"); grid = -1; return; }
        int per_cu = 0;
        if (hipOccupancyMaxActiveBlocksPerMultiprocessor(&per_cu, (const void*)fwd_kernel, NTHREADS, LDS_BYTES) != hipSuccess || per_cu < 1) { fprintf(stderr, "kernel_launch: occupancy query says %d\n", per_cu); }
        (void)hipGetLastError();
        grid = cus;
    }
    if (grid < 0) return;
    (void)hipMemsetAsync((char*)d_ws + WS_CTL, 0, CTL_ZERO_BYTES, stream);
    Args a{};
    for (int i = 0; i < 17; ++i) a.in[i] = (const float*)d_in[i];
    a.out = (float*)d_out; a.ws = (unsigned char*)d_ws;
#if MK_PER_PHASE
    for (int p = 0; p < N_PHASES; ++p) { a.ph_lo = p; a.ph_hi = p + 1; hipLaunchKernelGGL(fwd_kernel, dim3(grid), dim3(NTHREADS), LDS_BYTES, stream, a); }
#else
    a.ph_lo = 0; a.ph_hi = N_PHASES;
    hipLaunchKernelGGL(fwd_kernel, dim3(grid), dim3(NTHREADS), LDS_BYTES, stream, a);
#endif
}
```
